# Optimizing an MI355X kernel written in HIP

```python
import jax
import jax.numpy as jnp
from jax import lax
import numpy as np

D_MODEL = 1024
BATCH = 4
SEQ = 4096
DEPTH = 2

CHUNK = 64
QBLOCK = 128
ROPE_THETA = 500000.0
NORM_EPS = 1e-6

SB_HEADS = 8
SB_HEAD_DIM = 64
SGU_GROUPS = 8
SGU_GROUP_DIM = 64
SGU_CHUNK = 128
AB_SPLITS = (SB_HEADS * SB_HEAD_DIM, SB_HEADS * SB_HEAD_DIM, SB_HEADS * SB_HEAD_DIM,
             SGU_GROUPS * SGU_GROUP_DIM, SGU_GROUPS * SGU_GROUP_DIM)
AB_COLS = sum(AB_SPLITS)
AB_MIX = SB_HEADS * SB_HEAD_DIM + SGU_GROUPS * SGU_GROUP_DIM

MLA_HEADS = 8
MLA_Q_RANK = 256
MLA_KV_RANK = 128
MLA_ROPE_DIM = 32
MLA_NOPE_DIM = 64
MLA_V_DIM = 64
DSA_HEADS = 8
DSA_HEAD_DIM = 64
DSA_ROT_DIM = DSA_HEAD_DIM // 4
IDX_HEADS = 8
IDX_HEAD_DIM = 32
IDX_ROT_DIM = IDX_HEAD_DIM // 4
INDEX_TOPK = 256
CD_SPLITS = (MLA_Q_RANK, MLA_KV_RANK, MLA_ROPE_DIM,
             DSA_HEADS * DSA_HEAD_DIM, DSA_HEADS * DSA_HEAD_DIM, DSA_HEADS * DSA_HEAD_DIM,
             IDX_HEADS * IDX_HEAD_DIM, IDX_HEAD_DIM, IDX_HEADS)
CD_COLS = sum(CD_SPLITS)
CD_MIX = MLA_HEADS * MLA_V_DIM + DSA_HEADS * DSA_HEAD_DIM

MOE_GROUPS = 4
EXPERTS_PER_GROUP = 4
N_EXPERTS = MOE_GROUPS * EXPERTS_PER_GROUP
EXPERT_TOPK = 2
D_EXPERT = 512

N_EVEN_LAYERS = (DEPTH + 1) // 2
N_ODD_LAYERS = DEPTH // 2

kernel_name = 'hybrid_stickbreak_sgu_mla_dsa_hmoe'


def rms_norm(x, g):
    x32 = x.astype(jnp.float32)
    y = x32 * lax.rsqrt(jnp.mean(x32 * x32, axis=-1, keepdims=True) + NORM_EPS)
    return (y * g.astype(jnp.float32)).astype(x.dtype)


def rotary(x, positions, rot_dim):
    half = rot_dim // 2
    inv_freq = jnp.power(jnp.float32(ROPE_THETA), -jnp.arange(half, dtype=jnp.float32) * (2.0 / rot_dim))
    ang = positions.astype(jnp.float32)[:, :, None, None] * inv_freq
    cos, sin = jnp.cos(ang), jnp.sin(ang)
    x32 = x.astype(jnp.float32)
    x1, x2 = x32[..., :half], x32[..., half:rot_dim]
    out = jnp.concatenate([x1 * cos - x2 * sin, x2 * cos + x1 * sin, x32[..., rot_dim:]], axis=-1)
    return out.astype(x.dtype)


def split_cols(t, sizes):
    return jnp.split(t, [int(c) for c in np.cumsum(sizes)[:-1]], axis=-1)


def to_blocks(t):
    b, s = t.shape[0], t.shape[1]
    return jnp.swapaxes(t.reshape((b, s // QBLOCK, QBLOCK) + t.shape[2:]), 0, 1)


def from_blocks(t):
    nb, b = t.shape[0], t.shape[1]
    t = jnp.swapaxes(t, 0, 1)
    return t.reshape((b, nb * QBLOCK) + t.shape[3:])


def stick_breaking_attention(q, k, v):
    s_len, d = q.shape[1], q.shape[-1]
    scale = d ** -0.5
    key_pos = jnp.arange(s_len)

    def one_block(args):
        q_blk, blk = args
        q_pos = blk * QBLOCK + jnp.arange(QBLOCK)
        strict = key_pos[None, :] < q_pos[:, None]
        z = jnp.einsum('bqhd,bshd->bhqs', q_blk, k).astype(jnp.float32) * scale
        log_not = jnp.where(strict, -jax.nn.softplus(z), 0.0)
        later = lax.cumsum(log_not, axis=3, reverse=True) - log_not
        w = jnp.where(strict, jnp.exp(jax.nn.log_sigmoid(z) + later), 0.0)
        return jnp.einsum('bhqs,bshd->bqhd', w.astype(v.dtype), v)

    return from_blocks(lax.map(one_block, (to_blocks(q), jnp.arange(s_len // QBLOCK))))


def spatial_gating(u, z, norm_g, w_s, b_s):
    b, s_len, g, dg = z.shape
    z = rms_norm(z, norm_g)
    zc = z.reshape(b, s_len // SGU_CHUNK, SGU_CHUNK, g, dg)
    i = jnp.arange(SGU_CHUNK) // CHUNK
    visible = i[None, :] <= i[:, None]
    w = jnp.where(visible[None], w_s, 0.0).astype(z.dtype)
    mixed = jnp.einsum('gij,bnjgd->bnigd', w, zc) + jnp.swapaxes(b_s, 0, 1)[None, None, :, :, None]
    return u * mixed.reshape(b, s_len, g, dg)


def chunk_causal_attention(q, k, v):
    s_len = q.shape[1]
    scale = q.shape[-1] ** -0.5
    key_chunk = jnp.arange(s_len) // CHUNK

    def one_block(args):
        q_blk, blk = args
        q_chunk = (blk * QBLOCK + jnp.arange(QBLOCK)) // CHUNK
        visible = key_chunk[None, :] <= q_chunk[:, None]
        sc = jnp.einsum('bqhd,bshd->bhqs', q_blk, k).astype(jnp.float32) * scale
        p = jax.nn.softmax(jnp.where(visible, sc, -jnp.inf), axis=-1)
        return jnp.einsum('bhqs,bshd->bqhd', p.astype(v.dtype), v)

    return from_blocks(lax.map(one_block, (to_blocks(q), jnp.arange(s_len // QBLOCK))))


def indexed_sparse_attention(q, k, v, iq, ik, iw, topk):
    s_len = q.shape[1]
    scale = q.shape[-1] ** -0.5
    idx_scale = iq.shape[-1] ** -0.5
    key_chunk = jnp.arange(s_len) // CHUNK

    def one_block(args):
        q_blk, iq_blk, iw_blk, blk = args
        q_chunk = (blk * QBLOCK + jnp.arange(QBLOCK)) // CHUNK
        admissible = key_chunk[None, :] <= q_chunk[:, None]
        logits = jnp.einsum('bqhe,bse->bqhs', iq_blk, ik).astype(jnp.float32) * idx_scale
        score = jnp.einsum('bqh,bqhs->bqs', iw_blk.astype(jnp.float32), jax.nn.relu(logits))
        score = jnp.where(admissible[None], score, -jnp.inf)
        top_score, top_idx = lax.top_k(score, topk)
        valid = top_score > -jnp.inf
        k_sel = jax.vmap(lambda kb, ib: kb[ib])(k, top_idx)
        v_sel = jax.vmap(lambda vb, ib: vb[ib])(v, top_idx)
        sc = jnp.einsum('bqhd,bqkhd->bhqk', q_blk, k_sel).astype(jnp.float32) * scale
        p = jax.nn.softmax(jnp.where(valid[:, None], sc, -jnp.inf), axis=-1)
        return jnp.einsum('bhqk,bqkhd->bqhd', p.astype(v.dtype), v_sel)

    blocks = (to_blocks(q), to_blocks(iq), to_blocks(iw), jnp.arange(s_len // QBLOCK))
    return from_blocks(lax.map(one_block, blocks))


def even_mixer(h, w_in, sb_q_g, sb_k_g, sgu_g, w_s, b_s, w_out):
    b, s_len, _ = h.shape
    q, k, v, u, z = split_cols(h @ w_in, AB_SPLITS)
    hshape = (b, s_len, SB_HEADS, SB_HEAD_DIM)
    gshape = (b, s_len, SGU_GROUPS, SGU_GROUP_DIM)
    a_out = stick_breaking_attention(rms_norm(q.reshape(hshape), sb_q_g),
                                     rms_norm(k.reshape(hshape), sb_k_g), v.reshape(hshape))
    b_out = spatial_gating(jax.nn.gelu(u).reshape(gshape), jax.nn.gelu(z).reshape(gshape), sgu_g, w_s, b_s)
    mixed = jnp.concatenate([a_out.reshape(b, s_len, -1), b_out.reshape(b, s_len, -1)], axis=-1)
    return mixed @ w_out


def odd_mixer(h, positions, w_in, q_lat_g, kv_lat_g, w_uq, w_ukv, mla_q_g, mla_kn_g, mla_kr_g,
              dsa_q_g, dsa_k_g, w_out, topk):
    b, s_len, _ = h.shape
    c_q, c_kv, k_pe, q_d, k_d, v_d, iq, ik, iw = split_cols(h @ w_in, CD_SPLITS)
    q_c = (rms_norm(c_q, q_lat_g) @ w_uq).reshape(b, s_len, MLA_HEADS, MLA_ROPE_DIM + MLA_NOPE_DIM)
    kv_c = (rms_norm(c_kv, kv_lat_g) @ w_ukv).reshape(b, s_len, MLA_HEADS, MLA_NOPE_DIM + MLA_V_DIM)
    k_nope, v_c = kv_c[..., :MLA_NOPE_DIM], kv_c[..., MLA_NOPE_DIM:]
    q_c = rotary(rms_norm(q_c, mla_q_g), positions, MLA_ROPE_DIM)
    k_rope = rotary(rms_norm(k_pe, mla_kr_g)[:, :, None, :], positions, MLA_ROPE_DIM)
    k_c = jnp.concatenate([jnp.broadcast_to(k_rope, (b, s_len, MLA_HEADS, MLA_ROPE_DIM)),
                           rms_norm(k_nope, mla_kn_g)], axis=-1)
    c_out = chunk_causal_attention(q_c, k_c, v_c)
    dshape = (b, s_len, DSA_HEADS, DSA_HEAD_DIM)
    q_d = rotary(rms_norm(q_d.reshape(dshape), dsa_q_g), positions, DSA_ROT_DIM)
    k_d = rotary(rms_norm(k_d.reshape(dshape), dsa_k_g), positions, DSA_ROT_DIM)
    iq = rotary(iq.reshape(b, s_len, IDX_HEADS, IDX_HEAD_DIM), positions, IDX_ROT_DIM)
    ik = rotary(ik[:, :, None, :], positions, IDX_ROT_DIM)[:, :, 0]
    iw = iw * (IDX_HEADS ** -0.5)
    d_out = indexed_sparse_attention(q_d, k_d, v_d.reshape(dshape), iq, ik, iw, topk)
    mixed = jnp.concatenate([c_out.reshape(b, s_len, -1), d_out.reshape(b, s_len, -1)], axis=-1)
    return mixed @ w_out


def hierarchical_moe(h, w_group, b_group, w_expert, b_expert, w_gate, w_up, w_down):
    b, s_len, d = h.shape
    t = h.reshape(b * s_len, d)
    f32 = jnp.float32
    group_probs = jax.nn.softmax((t @ w_group).astype(f32) + b_group.astype(f32), axis=-1)
    p_group, g_idx = lax.top_k(group_probs, 1)
    expert_logits = jnp.einsum('td,gde->tge', t, w_expert).astype(f32) + b_expert.astype(f32)
    in_group = jnp.einsum('tge,tg->te', expert_logits, jax.nn.one_hot(g_idx[:, 0], MOE_GROUPS, dtype=f32))
    p_in, e_idx = lax.top_k(jax.nn.softmax(in_group, axis=-1), EXPERT_TOPK)
    combine = p_group * p_in / jnp.sum(p_in, axis=-1, keepdims=True)
    expert_id = g_idx * EXPERTS_PER_GROUP + e_idx
    gates = jnp.einsum('tk,tke->te', combine, jax.nn.one_hot(expert_id, N_EXPERTS, dtype=f32)).astype(h.dtype)
    y = jnp.zeros_like(t)
    for e in range(N_EXPERTS):
        hid = jax.nn.silu(t @ w_gate[e]) * (t @ w_up[e])
        y = y + (hid @ w_down[e]) * gates[:, e:e + 1]
    return y.reshape(b, s_len, d)


def setup_inputs(seed: int = 0) -> dict:
    key = jax.random.key(seed)
    keys = list(jax.random.split(key, 40))
    f32 = jnp.float32

    def normal(shape, scale):
        return jax.random.normal(keys.pop(), shape, f32) * scale

    def gain(shape):
        return 1.0 + 0.02 * jax.random.normal(keys.pop(), shape, f32)

    ne, no = N_EVEN_LAYERS, N_ODD_LAYERS
    x = normal((BATCH, SEQ, D_MODEL), 1.0)
    offset = jax.random.randint(keys.pop(), (BATCH, 1), 0, 256) * CHUNK
    positions = (offset + jnp.arange(SEQ)[None, :]).astype(jnp.int32)
    return {
        'x': x,
        'positions': positions,
        'ab_norm_g': gain((ne, D_MODEL)),
        'ab_w_in': normal((ne, D_MODEL, AB_COLS), D_MODEL ** -0.5),
        'sb_q_norm_g': gain((ne, SB_HEAD_DIM)),
        'sb_k_norm_g': gain((ne, SB_HEAD_DIM)),
        'sgu_norm_g': gain((ne, SGU_GROUPS, SGU_GROUP_DIM)),
        'sgu_w_s': normal((ne, SGU_GROUPS, SGU_CHUNK, SGU_CHUNK), SGU_CHUNK ** -0.5),
        'sgu_b_s': gain((ne, SGU_GROUPS, SGU_CHUNK)),
        'ab_w_out': normal((ne, AB_MIX, D_MODEL), AB_MIX ** -0.5),
        'cd_norm_g': gain((no, D_MODEL)),
        'cd_w_in': normal((no, D_MODEL, CD_COLS), D_MODEL ** -0.5),
        'mla_q_latent_norm_g': gain((no, MLA_Q_RANK)),
        'mla_kv_latent_norm_g': gain((no, MLA_KV_RANK)),
        'mla_w_uq': normal((no, MLA_Q_RANK, MLA_HEADS * (MLA_ROPE_DIM + MLA_NOPE_DIM)), MLA_Q_RANK ** -0.5),
        'mla_w_ukv': normal((no, MLA_KV_RANK, MLA_HEADS * (MLA_NOPE_DIM + MLA_V_DIM)), MLA_KV_RANK ** -0.5),
        'mla_q_norm_g': gain((no, MLA_ROPE_DIM + MLA_NOPE_DIM)),
        'mla_k_nope_norm_g': gain((no, MLA_NOPE_DIM)),
        'mla_k_rope_norm_g': gain((no, MLA_ROPE_DIM)),
        'dsa_q_norm_g': gain((no, DSA_HEAD_DIM)),
        'dsa_k_norm_g': gain((no, DSA_HEAD_DIM)),
        'cd_w_out': normal((no, CD_MIX, D_MODEL), CD_MIX ** -0.5),
        'ffn_norm_g': gain((DEPTH, D_MODEL)),
        'router_group_w': normal((DEPTH, D_MODEL, MOE_GROUPS), D_MODEL ** -0.5),
        'router_group_b': normal((DEPTH, MOE_GROUPS), 0.01),
        'router_expert_w': normal((DEPTH, MOE_GROUPS, D_MODEL, EXPERTS_PER_GROUP), D_MODEL ** -0.5),
        'router_expert_b': normal((DEPTH, MOE_GROUPS, EXPERTS_PER_GROUP), 0.01),
        'expert_w_gate': normal((DEPTH, N_EXPERTS, D_MODEL, D_EXPERT), D_MODEL ** -0.5),
        'expert_w_up': normal((DEPTH, N_EXPERTS, D_MODEL, D_EXPERT), D_MODEL ** -0.5),
        'expert_w_down': normal((DEPTH, N_EXPERTS, D_EXPERT, D_MODEL), D_EXPERT ** -0.5),
    }


def reference(x, positions, ab_norm_g, ab_w_in, sb_q_norm_g, sb_k_norm_g, sgu_norm_g, sgu_w_s, sgu_b_s,
              ab_w_out, cd_norm_g, cd_w_in, mla_q_latent_norm_g, mla_kv_latent_norm_g, mla_w_uq, mla_w_ukv,
              mla_q_norm_g, mla_k_nope_norm_g, mla_k_rope_norm_g, dsa_q_norm_g, dsa_k_norm_g, cd_w_out,
              ffn_norm_g, router_group_w, router_group_b, router_expert_w, router_expert_b,
              expert_w_gate, expert_w_up, expert_w_down):
    topk = min(INDEX_TOPK, x.shape[1] // 4)
    h = x
    for layer in range(DEPTH):
        i = layer // 2
        if layer % 2 == 0:
            h = h + even_mixer(rms_norm(h, ab_norm_g[i]), ab_w_in[i], sb_q_norm_g[i], sb_k_norm_g[i],
                               sgu_norm_g[i], sgu_w_s[i], sgu_b_s[i], ab_w_out[i])
        else:
            h = h + odd_mixer(rms_norm(h, cd_norm_g[i]), positions, cd_w_in[i], mla_q_latent_norm_g[i],
                              mla_kv_latent_norm_g[i], mla_w_uq[i], mla_w_ukv[i], mla_q_norm_g[i],
                              mla_k_nope_norm_g[i], mla_k_rope_norm_g[i], dsa_q_norm_g[i], dsa_k_norm_g[i],
                              cd_w_out[i], topk)
        h = h + hierarchical_moe(rms_norm(h, ffn_norm_g[layer]), router_group_w[layer], router_group_b[layer],
                                 router_expert_w[layer], router_expert_b[layer], expert_w_gate[layer],
                                 expert_w_up[layer], expert_w_down[layer])
    return h
```

```cpp
#include <hip/hip_runtime.h>
#include <cstdio>
#include <cstdint>
#include <cmath>

#define DI __device__ __forceinline__
#define LAS __attribute__((address_space(3)))
typedef unsigned short u16;
typedef short bf16x8 __attribute__((ext_vector_type(8)));
typedef float f32x4 __attribute__((ext_vector_type(4)));
typedef float f32x16 __attribute__((ext_vector_type(16)));
typedef unsigned u32x4 __attribute__((ext_vector_type(4)));
typedef unsigned u32x2 __attribute__((ext_vector_type(2)));
typedef __bf16 bf16x2_t __attribute__((ext_vector_type(2)));
typedef float f32x2_t __attribute__((ext_vector_type(2)));

constexpr int T_ = 16384, D_ = 1024, B_ = 4, S_ = 4096;
constexpr int AB_COLS = 2560, CD_COLS = 2248, CD_PAD = 2304;
constexpr float EPS = 1e-6f;

constexpr size_t WS_CTL    = 0;
constexpr size_t CTL_BYTES = 65536;
constexpr size_t WS_WABIN  = WS_CTL + CTL_BYTES;
constexpr size_t WS_WABOUT = WS_WABIN + (size_t)2560 * 1024 * 2;
constexpr size_t WS_WCDIN  = WS_WABOUT + (size_t)1024 * 1024 * 2;
constexpr size_t WS_WUQ    = WS_WCDIN + (size_t)2304 * 1024 * 2;
constexpr size_t WS_WUKV   = WS_WUQ + (size_t)768 * 256 * 2;
constexpr size_t WS_WCDOUT = WS_WUKV + (size_t)1024 * 256 * 2;
constexpr size_t WS_WSGU   = WS_WCDOUT + (size_t)1024 * 1024 * 2;
constexpr size_t WS_EXP    = WS_WSGU + (size_t)8 * 128 * 128 * 2;
constexpr size_t WS_WGU    = WS_EXP;
constexpr size_t WS_WDN    = WS_EXP + (size_t)16 * 1024 * 1024 * 2;
constexpr size_t WS_MIXED  = WS_EXP;
constexpr size_t EXP_BYTES = (size_t)16 * 1024 * 1024 * 2 + (size_t)16 * 1024 * 512 * 2;
constexpr size_t WS_R1     = WS_EXP + EXP_BYTES;
constexpr size_t R1_BYTES  = (size_t)T_ * 2560 * 2;
constexpr size_t WS_R2     = WS_R1 + R1_BYTES;
constexpr size_t R2_BYTES  = (size_t)36864 * 512 * 2;
constexpr size_t WS_R4     = WS_R2 + R2_BYTES;
constexpr size_t R4_BYTES  = (size_t)36864 * 1024 * 2;
constexpr size_t WS_MISC   = WS_R4 + R4_BYTES;
constexpr size_t WS_END    = WS_MISC + (size_t)8 * 1024 * 1024;

constexpr size_t WS_PROJ = WS_R1, WS_XN = WS_R2, WS_VT = WS_R4, WS_ZT = WS_R4 + (size_t)T_ * 512 * 2;

constexpr size_t WS_PROJ1 = WS_R1, WS_MASK = WS_R1 + (size_t)T_ * 2304 * 2, WS_KVR = WS_R2;
constexpr size_t WS_LAT = WS_R4, WS_QCR = WS_R4 + (size_t)T_ * 512 * 2, WS_VCT = WS_QCR + (size_t)T_ * 768 * 2, WS_VDT = WS_VCT + (size_t)T_ * 512 * 2;
constexpr size_t MISC_KROPE = 1048576, MISC_IKP = 2097152, MISC_IWP = 3145728;
constexpr size_t MISC_TOKE = 0, MISC_TOKC = 65536, MISC_POS = 196608, MISC_CNT = 327680, MISC_SEG = 344064;
constexpr int LDS_TAB = 131072;
constexpr int LDS_BYTES = 147456;
constexpr int LDS_BARW  = LDS_BYTES - 16;

DI unsigned pack_bf2(float lo, float hi) { f32x2_t v = {lo, hi}; bf16x2_t r = __builtin_convertvector(v, bf16x2_t); return __builtin_bit_cast(unsigned, r); }
DI float bf_lo(unsigned u) { return __uint_as_float(u << 16); }
DI float bf_hi(unsigned u) { return __uint_as_float(u & 0xffff0000u); }
DI float wave_sum(float v) {
#pragma unroll
    for (int o = 32; o >= 1; o >>= 1) v += __shfl_xor(v, o);
    return v;
}
DI float gelu_tanh(float x) {
    const float y = 0.7978845608028654f * (x + 0.044715f * x * x * x);
    const float e = __expf(2.f * y);
    const float th = 1.f - 2.f / (1.f + e);
    return 0.5f * x * (1.f + th);
}

#define XB_TMO      128
#define XB_XCNT(j)  (256  + 64 * (j))
#define XB_XSUB(j)  (1280 + 64 * (j))
#define XB_XGEN(j)  (2304 + 64 * (j))
#define XB_TOP      3328
#define XB_TOPGEN   3392
#define XCD_BAR_WORDS 3456
#define XB_SPIN_CAP (1u << 18)

__device__ __forceinline__ unsigned xb_ld(unsigned* p)              { return __hip_atomic_load(p, __ATOMIC_RELAXED, __HIP_MEMORY_SCOPE_AGENT); }
__device__ __forceinline__ unsigned xb_add(unsigned* p, unsigned v) { return __hip_atomic_fetch_add(p, v, __ATOMIC_RELAXED, __HIP_MEMORY_SCOPE_AGENT); }
__device__ __forceinline__ unsigned xb_xcc_id() { return (unsigned)__builtin_amdgcn_s_getreg((3 << 11) | 20) & 0xFu; }
#define XB_SPIN(cond, bar) do { unsigned _sp = 0; while (cond) { __builtin_amdgcn_s_sleep(1); \
    if ((++_sp & 255u) == 0u) { if (xb_ld(&(bar)[XB_TMO])) break; if (_sp > XB_SPIN_CAP) { atomicAdd(&(bar)[XB_TMO], 1u); break; } } } } while (0)

struct XcdBarrier { unsigned* bar; unsigned x; volatile LAS unsigned* st; };

__device__ __forceinline__ XcdBarrier xcd_barrier_post(unsigned* bar, volatile LAS unsigned* st) {
    XcdBarrier b; b.bar = bar; b.x = xb_xcc_id(); b.st = st;
    if (threadIdx.x == 0) (void)xb_add(&bar[XB_XCNT(b.x)], 1u);
    return b;
}
__device__ __forceinline__ void xcd_barrier_complete(unsigned* bar, unsigned x, unsigned& nloc, unsigned& nx) {
    const unsigned G = gridDim.x * gridDim.y * gridDim.z;
    unsigned sum, cnt, mine, sp = 0u;
    for (;;) {
        sum = 0u; cnt = 0u; mine = 0u;
#pragma unroll
        for (unsigned j = 0; j < 16; ++j) { const unsigned c = xb_ld(&bar[XB_XCNT(j)]); sum += c; cnt += (c > 0u) ? 1u : 0u; mine = (j == x) ? c : mine; }
        if (sum == G) break;
        __builtin_amdgcn_s_sleep(1);
        if ((++sp & 255u) == 0u) { if (xb_ld(&bar[XB_TMO])) break; if (sp > XB_SPIN_CAP) { atomicAdd(&bar[XB_TMO], 1u); break; } }
    }
    nloc = mine > 0u ? mine : 1u; nx = cnt > 0u ? cnt : 1u;
}
__device__ __forceinline__ void xcd_barrier(const XcdBarrier& b) {
    asm volatile("s_waitcnt vmcnt(0)" ::: "memory");
    __syncthreads();
    if (threadIdx.x == 0) {
        unsigned* bar = b.bar;
        __builtin_amdgcn_s_waitcnt(0);
        unsigned nloc = b.st[0], nx = b.st[1];
        if (nloc == 0u) { xcd_barrier_complete(bar, b.x, nloc, nx); b.st[0] = nloc; b.st[1] = nx; }
        const unsigned old = xb_add(&bar[XB_XSUB(b.x)], 1u);
        const unsigned gen = old / nloc;
        if (old + 1u == (gen + 1u) * nloc) {
            __builtin_amdgcn_fence(__ATOMIC_RELEASE, "agent");
            asm volatile("s_waitcnt vmcnt(0)" ::: "memory");
            const unsigned og = xb_add(&bar[XB_TOP], 1u);
            const unsigned tg = og / nx;
            if (og + 1u == (tg + 1u) * nx) xb_add(&bar[XB_TOPGEN], 1u);
            else XB_SPIN(xb_ld(&bar[XB_TOPGEN]) == tg, bar);
            __builtin_amdgcn_fence(__ATOMIC_ACQUIRE, "agent");
            xb_add(&bar[XB_XGEN(b.x)], 1u);
            asm volatile("s_waitcnt vmcnt(0)" ::: "memory");
        } else {
            XB_SPIN(xb_ld(&bar[XB_XGEN(b.x)]) == gen, bar);
            __builtin_amdgcn_fence(__ATOMIC_ACQUIRE, "agent");
            asm volatile("s_waitcnt vmcnt(0)" ::: "memory");
        }
    }
    __syncthreads();
}

namespace pg8 {
constexpr int BM = 256, BK = 64, HALF = 128, HTB = HALF * BK * 2, STAGE_BYTES = 8 * HTB, NXCD = 8, WGM = 8;
DI int lds_byte(int r, int c) { const int st = (r >> 4) * 2 + (c >> 5), rr = r & 15, cc = c & 31, ob = rr * 64 + cc * 2; return st * 1024 + (ob ^ (((ob >> 9) & 1) << 5)); }
DI void stage_rc(int b, int& R, int& C) { const int st = b / 1024, sb = b % 1024, swz = sb ^ (((sb >> 9) & 1) << 5); R = (st >> 1) * 16 + swz / 64; C = (st & 1) * 32 + (swz % 64) / 2; }
DI int perm32(int rho) { const int n = rho >> 4, i = rho & 15; return 8 * (i >> 2) + 4 * n + (i & 3); }

struct Unit { int pm, pn; };
struct Gemm { const u16* A; const u16* Bt; int lda, ldb, K; };

struct StaticOrder {
    int nM, nN, nwg, G, c;
    DI void init(int M, int N, int G_, int c_) { nM = M / BM; nN = N / BM; nwg = nM * nN; G = G_; c = c_; }
    DI bool next(int i, Unit& u) const {
        const long L = (long)i * G + c; if (L >= nwg) return false;
        int wgid = (int)L; { const int q = nwg / NXCD, r = nwg % NXCD, xcd = wgid % NXCD, off = wgid / NXCD; wgid = (xcd < r ? xcd * (q + 1) : r * (q + 1) + (xcd - r) * q) + off; }
        const int nig = WGM * nN, gid = wgid / nig, fm = gid * WGM, gsz = (nM - fm) < WGM ? (nM - fm) : WGM;
        u.pm = fm + ((wgid % nig) % gsz); u.pn = (wgid % nig) / gsz; return true;
    }
};

template <class Epi, class Sched>
DI void gemm_phase(LAS unsigned char* lds, const Gemm g, const Sched& S, const Epi& E) {
    const int tid = threadIdx.x, wid = __builtin_amdgcn_readfirstlane(tid >> 6), lane = tid & 63, wr = wid >> 2, wc = wid & 3, fr = lane & 15, fq = lane >> 4;
    const int K = g.K, nt = K / BK;
    unsigned voffA[2], voffB[2];
#pragma unroll
    for (int i = 0; i < 2; ++i) { int R, C; stage_rc(tid * 16 + i * 8192, R, C); const int Rb = Epi::PERM ? ((R & ~31) + perm32(R & 31)) : R;
        voffA[i] = (unsigned)(R * g.lda + C) * 2u; voffB[i] = (unsigned)(Rb * g.ldb + C) * 2u; }
    const size_t kstep = (size_t)(BK * 2);
    const size_t hstepA = (size_t)HALF * g.lda * 2, hstepB = (size_t)HALF * g.ldb * 2;
    const size_t tstepA = 2 * hstepA, tstepB = 2 * hstepB;
    const unsigned ldsw = (unsigned)wid * 1024u;
    const int aoff = lds_byte(wr * 64 + fr, fq * 8), boff = lds_byte(wc * 32 + fr, fq * 8);
#define PG8_SA(b, h) (((b) * 2 + (h)) * HTB)
#define PG8_SB(b, h) ((4 + (b) * 2 + (h)) * HTB)
#define PG8_STAGE(bufoff, gbase, voff) do { _Pragma("unroll") for (int _i = 0; _i < 2; ++_i) \
        __builtin_amdgcn_global_load_lds((const unsigned*)((const char*)(gbase) + (voff)[_i]), (LAS unsigned*)(lds + (bufoff) + ldsw + _i * 8192), 16, 0, 0); } while (0)
#define PG8_LDA(dst, b, h) do { _Pragma("unroll") for (int m = 0; m < 4; ++m) _Pragma("unroll") for (int k = 0; k < 2; ++k) dst[m][k] = *(const LAS bf16x8*)(lds + PG8_SA(b, h) + aoff + m * 2048 + k * 1024); } while (0)
#define PG8_LDB(dst, b, h) do { _Pragma("unroll") for (int n = 0; n < 2; ++n) _Pragma("unroll") for (int k = 0; k < 2; ++k) dst[n][k] = *(const LAS bf16x8*)(lds + PG8_SB(b, h) + boff + n * 2048 + k * 1024); } while (0)
#define PG8_MMA(ai, bj, At, Bt) do { __builtin_amdgcn_s_setprio(1); _Pragma("unroll") for (int m = 0; m < 4; ++m) _Pragma("unroll") for (int n = 0; n < 2; ++n) _Pragma("unroll") for (int k = 0; k < 2; ++k) \
        acc[ai][bj][m][n] = __builtin_amdgcn_mfma_f32_16x16x32_bf16(Bt[n][k], At[m][k], acc[ai][bj][m][n], 0, 0, 0); __builtin_amdgcn_s_setprio(0); } while (0)
#define PG8_WAIT_V(n) asm volatile("s_waitcnt vmcnt(" #n ")" ::: "memory")
#define PG8_WAIT_L(n) asm volatile("s_waitcnt lgkmcnt(" #n ")" ::: "memory")
#define PG8_BAR __builtin_amdgcn_s_barrier()
#define PG8_SCHED __builtin_amdgcn_sched_barrier(0)
    Unit cur, nxt; int ui = 0;
    if (!S.next(0, cur)) return;
    f32x4 acc[2][2][4][2];
#pragma unroll
    for (int a = 0; a < 2; ++a)
#pragma unroll
        for (int b = 0; b < 2; ++b)
#pragma unroll
            for (int m = 0; m < 4; ++m)
#pragma unroll
                for (int n = 0; n < 2; ++n) acc[a][b][m][n] = (f32x4){0.f, 0.f, 0.f, 0.f};
    bf16x8 At[4][2], B0[2][2], B1[2][2];
    const char* cA = (const char*)g.A + (size_t)cur.pm * tstepA; const char* cB = (const char*)g.Bt + (size_t)cur.pn * tstepB;
    PG8_STAGE(PG8_SB(0, 0), cB, voffB); PG8_STAGE(PG8_SA(0, 0), cA, voffA); PG8_STAGE(PG8_SB(0, 1), cB + hstepB, voffB); PG8_STAGE(PG8_SA(0, 1), cA + hstepA, voffA);
    if (wr == 1) PG8_BAR;
    PG8_WAIT_V(4); PG8_BAR;
    PG8_STAGE(PG8_SB(1, 0), cB + kstep, voffB); PG8_STAGE(PG8_SA(1, 0), cA + kstep, voffA); PG8_STAGE(PG8_SB(1, 1), cB + hstepB + kstep, voffB);
    PG8_WAIT_V(6); PG8_BAR;
    for (;;) {
        const bool has_next = S.next(ui + 1, nxt);
        const char* nA = has_next ? (const char*)g.A + (size_t)nxt.pm * tstepA : cA; const char* nB = has_next ? (const char*)g.Bt + (size_t)nxt.pn * tstepB : cB;
        for (int t = 0; t < nt; t += 2) {
            const bool last = (t == nt - 2);
            const char* a1 = cA + (size_t)(t + 1) * kstep;
            const char* a2 = last ? nA : cA + (size_t)(t + 2) * kstep; const char* b2 = last ? nB : cB + (size_t)(t + 2) * kstep;
            const char* a3 = a2 + kstep; const char* b3 = b2 + kstep;
            PG8_LDB(B0, 0, 0); PG8_SCHED; PG8_LDA(At, 0, 0); PG8_STAGE(PG8_SA(1, 1), a1 + hstepA, voffA);
            PG8_WAIT_L(8); PG8_BAR; PG8_WAIT_L(0); PG8_MMA(0, 0, At, B0); PG8_BAR; PG8_SCHED;
            PG8_LDB(B1, 0, 1); PG8_STAGE(PG8_SB(0, 0), b2, voffB);
            PG8_BAR; PG8_WAIT_L(0); PG8_MMA(0, 1, At, B1); PG8_BAR;
            PG8_LDA(At, 0, 1); PG8_STAGE(PG8_SA(0, 0), a2, voffA);
            PG8_BAR; PG8_WAIT_L(0); PG8_MMA(1, 0, At, B0); PG8_BAR; PG8_SCHED;
            PG8_STAGE(PG8_SB(0, 1), b2 + hstepB, voffB);
            PG8_WAIT_V(6); PG8_BAR; PG8_MMA(1, 1, At, B1); PG8_BAR;
            PG8_LDB(B0, 1, 0); PG8_SCHED; PG8_LDA(At, 1, 0); PG8_STAGE(PG8_SA(0, 1), a2 + hstepA, voffA);
            PG8_WAIT_L(8); PG8_BAR; PG8_WAIT_L(0); PG8_MMA(0, 0, At, B0); PG8_BAR; PG8_SCHED;
            PG8_LDB(B1, 1, 1); PG8_STAGE(PG8_SB(1, 0), b3, voffB);
            PG8_BAR; PG8_WAIT_L(0); PG8_MMA(0, 1, At, B1); PG8_BAR;
            PG8_LDA(At, 1, 1); PG8_STAGE(PG8_SA(1, 0), a3, voffA);
            PG8_BAR; PG8_WAIT_L(0); PG8_MMA(1, 0, At, B0); PG8_BAR; PG8_SCHED;
            PG8_STAGE(PG8_SB(1, 1), b3 + hstepB, voffB);
            PG8_WAIT_V(6); PG8_BAR; PG8_MMA(1, 1, At, B1); PG8_BAR;
        }
        E(acc, cur, wr, wc, fr, fq);
        if (!has_next) break;
#pragma unroll
        for (int a = 0; a < 2; ++a)
#pragma unroll
            for (int b = 0; b < 2; ++b)
#pragma unroll
                for (int m = 0; m < 4; ++m)
#pragma unroll
                    for (int n = 0; n < 2; ++n) acc[a][b][m][n] = (f32x4){0.f, 0.f, 0.f, 0.f};
        cur = nxt; cA = nA; cB = nB; ++ui;
    }
    PG8_WAIT_V(0);
    if (wr == 0) PG8_BAR;
    PG8_BAR;
#undef PG8_SA
#undef PG8_SB
#undef PG8_STAGE
#undef PG8_LDA
#undef PG8_LDB
#undef PG8_MMA
#undef PG8_WAIT_V
#undef PG8_WAIT_L
#undef PG8_BAR
#undef PG8_SCHED
}

struct EpiBf16 {
    static constexpr bool PERM = true;
    u16* O; int ldc; int pnmask;
    DI void operator()(const f32x4 (&acc)[2][2][4][2], const Unit& u, int wr, int wc, int fr, int fq) const {
        const int row0 = u.pm * BM + wr * 64 + fr, col0 = (u.pn & pnmask) * BM + wc * 32 + 8 * fq;
#pragma unroll
        for (int ai = 0; ai < 2; ++ai)
#pragma unroll
            for (int m = 0; m < 4; ++m) { u16* rowp = O + (size_t)(row0 + ai * HALF + m * 16) * ldc + col0;
#pragma unroll
                for (int bj = 0; bj < 2; ++bj) { const f32x4 v0 = acc[ai][bj][m][0], v1 = acc[ai][bj][m][1];
                    u32x4 w; w.x = pack_bf2(v0[0], v0[1]); w.y = pack_bf2(v0[2], v0[3]); w.z = pack_bf2(v1[0], v1[1]); w.w = pack_bf2(v1[2], v1[3]);
                    *(u32x4*)(rowp + bj * HALF) = w; } }
    }
};
struct EpiF32Res {
    static constexpr bool PERM = false;
    float* C; const float* R; int ldc;
    DI void operator()(const f32x4 (&acc)[2][2][4][2], const Unit& u, int wr, int wc, int fr, int fq) const {
        const int row0 = u.pm * BM + wr * 64 + fr, col0 = u.pn * BM + wc * 32 + 4 * fq;
#pragma unroll
        for (int ai = 0; ai < 2; ++ai)
#pragma unroll
            for (int m = 0; m < 4; ++m) { const size_t ro = (size_t)(row0 + ai * HALF + m * 16) * ldc + col0;
#pragma unroll
                for (int bj = 0; bj < 2; ++bj)
#pragma unroll
                    for (int n = 0; n < 2; ++n) { const f32x4 r = *(const f32x4*)(R + ro + bj * HALF + n * 16); *(f32x4*)(C + ro + bj * HALF + n * 16) = acc[ai][bj][m][n] + r; } }
    }
};

struct EpiGU {
    static constexpr bool PERM = false;
    u16* H;
    DI void operator()(const f32x4 (&acc)[2][2][4][2], const Unit& u, int wr, int wc, int fr, int fq) const {
        const int row0 = u.pm * BM + wr * 64 + fr, pnl = u.pn & 3;
#pragma unroll
        for (int ai = 0; ai < 2; ++ai)
#pragma unroll
            for (int m = 0; m < 4; ++m) { u16* rowp = H + (size_t)(row0 + ai * HALF + m * 16) * 512;
#pragma unroll
                for (int bj = 0; bj < 2; ++bj) { const f32x4 gv = acc[ai][bj][m][0], uv = acc[ai][bj][m][1];
                    float hv[4];
#pragma unroll
                    for (int j = 0; j < 4; ++j) hv[j] = gv[j] / (1.f + __expf(-gv[j])) * uv[j];
                    u32x2 w; w.x = pack_bf2(hv[0], hv[1]); w.y = pack_bf2(hv[2], hv[3]);
                    *(u32x2*)(rowp + 16 * (8 * pnl + 4 * bj + wc) + 4 * fq) = w; } }
    }
};
struct MoeOrder {
    const LAS int* seg; int G, c;
    DI bool next(int i, Unit& u) const {
        const int L = i * G + c, ntr = seg[16] >> 8; if (L >= ntr * 4) return false;
        const int pm = L >> 2; int e = 0;
#pragma unroll
        for (int k = 1; k < 16; ++k) e += (pm * 256 >= seg[k]) ? 1 : 0;
        u.pm = pm; u.pn = e * 4 + (L & 3); return true;
    }
};
}

struct Params {
    const float* in[30];
    float* out;
    unsigned char* ws;
    int ph_lo, ph_hi;
    double invf[32];
};

DI void cvt_tile(LAS unsigned char* lds, const float* src, int ld_src, int n_valid, int k0, int n0, u16* dst, int ld_dst, int mode) {
    LAS float* tile = (LAS float*)lds;
    const int tid = threadIdx.x;
#pragma unroll
    for (int i = 0; i < 2; ++i) {
        const int e = tid + i * 512, kk = e >> 4, n4 = (e & 15) * 4;
        f32x4 v = (f32x4){0.f, 0.f, 0.f, 0.f};
        if (n0 + n4 < n_valid) v = *(const f32x4*)(src + (size_t)(k0 + kk) * ld_src + n0 + n4);
        tile[kk * 65 + n4 + 0] = v[0]; tile[kk * 65 + n4 + 1] = v[1]; tile[kk * 65 + n4 + 2] = v[2]; tile[kk * 65 + n4 + 3] = v[3];
    }
    __syncthreads();
    {
        const int nn = tid >> 3, kc = (tid & 7) * 8;
        float f[8];
#pragma unroll
        for (int j = 0; j < 8; ++j) f[j] = tile[(kc + j) * 65 + nn];
        const int n = n0 + nn;
        const int drow = mode == 0 ? n : (32 * (n >> 4) + (n & 15) + (mode == 2 ? 16 : 0));
        u32x4 w; w.x = pack_bf2(f[0], f[1]); w.y = pack_bf2(f[2], f[3]); w.z = pack_bf2(f[4], f[5]); w.w = pack_bf2(f[6], f[7]);
        *(u32x4*)(dst + (size_t)drow * ld_dst + k0 + kc) = w;
    }
    __syncthreads();
}
DI int cvt_matrix(LAS unsigned char* lds, int base, const float* src, int K, int N, int n_valid, u16* dst, int ld_dst, int mode) {
    const int tn = N / 64, ntile = (K / 64) * tn, G = gridDim.x;
    const int first = ((int)blockIdx.x - base % G + G) % G;
    for (int t = first; t < ntile; t += G) cvt_tile(lds, src, n_valid, n_valid, (t / tn) * 64, (t % tn) * 64, dst, ld_dst, mode);
    return base + ntile;
}

DI void rmsnorm_rows(const float* src, const float* g, u16* dst) {
    const int lane = threadIdx.x & 63, wave = threadIdx.x >> 6;
    f32x4 gv[4];
#pragma unroll
    for (int i = 0; i < 4; ++i) gv[i] = *(const f32x4*)(g + lane * 4 + 256 * i);
    for (int row = blockIdx.x * 8 + wave; row < T_; row += gridDim.x * 8) {
        const float* p = src + (size_t)row * D_;
        f32x4 v[4]; float ss = 0.f;
#pragma unroll
        for (int i = 0; i < 4; ++i) { v[i] = *(const f32x4*)(p + lane * 4 + 256 * i); ss += v[i][0] * v[i][0] + v[i][1] * v[i][1] + v[i][2] * v[i][2] + v[i][3] * v[i][3]; }
        ss = wave_sum(ss);
        const float r = rsqrtf(ss * (1.f / D_) + EPS);
#pragma unroll
        for (int i = 0; i < 4; ++i) { u32x2 w; w.x = pack_bf2(v[i][0] * r * gv[i][0], v[i][1] * r * gv[i][1]); w.y = pack_bf2(v[i][2] * r * gv[i][2], v[i][3] * r * gv[i][3]);
            *(u32x2*)(dst + (size_t)row * D_ + lane * 4 + 256 * i) = w; }
    }
}

DI int vperm16(int p) { const int hh = p >> 3, j = p & 7; return 8 * (j >> 2) + 4 * hh + (j & 3); }
DI void post_l0(LAS unsigned char* lds, u16* proj, const float* qg, const float* kg, const float* zg, u16* vt, u16* zt) {
    const int tid = threadIdx.x, lane = tid & 63, wave = tid >> 6;
    LAS u16* vtile = (LAS u16*)lds;
    LAS u16* ztile = (LAS u16*)(lds + 65536);
    for (int unit = blockIdx.x; unit < T_ / 64; unit += gridDim.x) {
        const int tok0 = unit * 64;
        for (int tl = wave * 8; tl < wave * 8 + 8; ++tl) {
            u16* row = proj + (size_t)(tok0 + tl) * AB_COLS;
            const int d0 = (lane & 7) * 8;
#pragma unroll
            for (int i = 0; i < 2; ++i) {
                u32x4 w = *(const u32x4*)(row + i * 512 + lane * 8);
                float f[8] = {bf_lo(w.x), bf_hi(w.x), bf_lo(w.y), bf_hi(w.y), bf_lo(w.z), bf_hi(w.z), bf_lo(w.w), bf_hi(w.w)};
                float ss = 0.f;
#pragma unroll
                for (int j = 0; j < 8; ++j) ss += f[j] * f[j];
                ss += __shfl_xor(ss, 1); ss += __shfl_xor(ss, 2); ss += __shfl_xor(ss, 4);
                const float r = rsqrtf(ss * (1.f / 64.f) + EPS);
                const float* gp = (i == 0 ? qg : kg) + d0;
#pragma unroll
                for (int j = 0; j < 8; ++j) f[j] = f[j] * r * gp[j];
                w.x = pack_bf2(f[0], f[1]); w.y = pack_bf2(f[2], f[3]); w.z = pack_bf2(f[4], f[5]); w.w = pack_bf2(f[6], f[7]);
                *(u32x4*)(row + i * 512 + lane * 8) = w;
            }
            { const u32x4 w = *(const u32x4*)(row + 1024 + lane * 8); *(LAS u32x4*)(vtile + tl * 512 + lane * 8) = w; }
            { u32x4 w = *(const u32x4*)(row + 1536 + lane * 8);
              float f[8] = {bf_lo(w.x), bf_hi(w.x), bf_lo(w.y), bf_hi(w.y), bf_lo(w.z), bf_hi(w.z), bf_lo(w.w), bf_hi(w.w)};
#pragma unroll
              for (int j = 0; j < 8; ++j) f[j] = gelu_tanh(f[j]);
              w.x = pack_bf2(f[0], f[1]); w.y = pack_bf2(f[2], f[3]); w.z = pack_bf2(f[4], f[5]); w.w = pack_bf2(f[6], f[7]);
              *(u32x4*)(row + 1536 + lane * 8) = w; }
            { u32x4 w = *(const u32x4*)(row + 2048 + lane * 8);
              float f[8] = {bf_lo(w.x), bf_hi(w.x), bf_lo(w.y), bf_hi(w.y), bf_lo(w.z), bf_hi(w.z), bf_lo(w.w), bf_hi(w.w)};
              float ss = 0.f;
#pragma unroll
              for (int j = 0; j < 8; ++j) { f[j] = gelu_tanh(f[j]); ss += f[j] * f[j]; }
              ss += __shfl_xor(ss, 1); ss += __shfl_xor(ss, 2); ss += __shfl_xor(ss, 4);
              const float r = rsqrtf(ss * (1.f / 64.f) + EPS);
              const float* gp = zg + lane * 8;
#pragma unroll
              for (int j = 0; j < 8; ++j) f[j] = f[j] * r * gp[j];
              w.x = pack_bf2(f[0], f[1]); w.y = pack_bf2(f[2], f[3]); w.z = pack_bf2(f[4], f[5]); w.w = pack_bf2(f[6], f[7]);
              *(LAS u32x4*)(ztile + tl * 512 + lane * 8) = w; }
        }
        __syncthreads();
        {
            const int col = tid, b = tok0 / S_, s0 = tok0 % S_;
            u16* vdst = vt + ((size_t)(b * 512 + col)) * S_ + s0;
            u16* zdst = zt + ((size_t)(b * 512 + col)) * S_ + s0;
#pragma unroll
            for (int c = 0; c < 8; ++c) {
                unsigned vw[4], zw[4];
#pragma unroll
                for (int j = 0; j < 4; ++j) {
                    const int p0 = c * 8 + 2 * j, p1 = p0 + 1;
                    const int k0 = (p0 & ~15) + vperm16(p0 & 15), k1 = (p1 & ~15) + vperm16(p1 & 15);
                    vw[j] = (unsigned)vtile[k0 * 512 + col] | ((unsigned)vtile[k1 * 512 + col] << 16);
                    zw[j] = (unsigned)ztile[p0 * 512 + col] | ((unsigned)ztile[p1 * 512 + col] << 16);
                }
                *(u32x4*)(vdst + c * 8) = (u32x4){vw[0], vw[1], vw[2], vw[3]};
                *(u32x4*)(zdst + c * 8) = (u32x4){zw[0], zw[1], zw[2], zw[3]};
            }
        }
        __syncthreads();
    }
}

constexpr int KP = 72;
DI void sb_attn_unit(LAS unsigned char* lds, const u16* proj, const u16* vt, u16* mixed, int b, int h, int qb) {
    const int tid = threadIdx.x, lane = tid & 63, wave = __builtin_amdgcn_readfirstlane(tid >> 6), r = lane & 31, hh = lane >> 5;
    LAS u16* Ks = (LAS u16*)lds;
    LAS u16* Vs = (LAS u16*)(lds + 64 * KP * 2);
    const int q0 = qb * 256, qrow = q0 + wave * 32 + r;
    const size_t tokq = (size_t)b * S_ + qrow;
    bf16x8 qf[4];
#pragma unroll
    for (int kk = 0; kk < 4; ++kk) qf[kk] = *(const bf16x8*)(proj + tokq * AB_COLS + h * 64 + kk * 16 + hh * 8);
    f32x16 o0, o1;
#pragma unroll
    for (int i = 0; i < 16; ++i) { o0[i] = 0.f; o1[i] = 0.f; }
    float carry = 0.f;
    const int wave_qmax = q0 + wave * 32 + 31;
    for (int kt = qb * 4 + 3; kt >= 0; --kt) {
        __syncthreads();
        {
            const int row = tid >> 3, c8 = (tid & 7) * 8;
            const u32x4 kv = *(const u32x4*)(proj + ((size_t)b * S_ + kt * 64 + row) * AB_COLS + 512 + h * 64 + c8);
            *(LAS u32x4*)(Ks + row * KP + c8) = kv;
            const u32x4 vv = *(const u32x4*)(vt + ((size_t)(b * 8 + h) * 64 + row) * S_ + kt * 64 + c8);
            *(LAS u32x4*)(Vs + row * KP + c8) = vv;
        }
        __syncthreads();
        if (kt * 64 >= wave_qmax) continue;
#pragma unroll
        for (int sub = 1; sub >= 0; --sub) {
            f32x16 s;
#pragma unroll
            for (int i = 0; i < 16; ++i) s[i] = 0.f;
#pragma unroll
            for (int kk = 0; kk < 4; ++kk) {
                const bf16x8 kf = *(const LAS bf16x8*)(Ks + (sub * 32 + r) * KP + kk * 16 + hh * 8);
                s = __builtin_amdgcn_mfma_f32_32x32x16_bf16(kf, qf[kk], s, 0, 0, 0);
            }
            const int kbase = kt * 64 + sub * 32 + 4 * hh;
            float a[16], z[16];
#pragma unroll
            for (int i = 0; i < 16; ++i) {
                const int key = kbase + (i & 3) + 8 * (i >> 2);
                z[i] = s[i] * 0.125f;
                const float sp = fmaxf(z[i], 0.f) + __logf(1.f + __expf(-fabsf(z[i])));
                a[i] = key < qrow ? sp : 0.f;
            }
            float bs[4], pbs[4];
#pragma unroll
            for (int g = 0; g < 4; ++g) { bs[g] = (a[4 * g] + a[4 * g + 1]) + (a[4 * g + 2] + a[4 * g + 3]); pbs[g] = __shfl_xor(bs[g], 32); }
            float suf = 0.f;
            f32x16 p;
#pragma unroll
            for (int g = 3; g >= 0; --g) {
                const float E = carry + suf + (hh == 0 ? pbs[g] : 0.f);
                float run = E;
#pragma unroll
                for (int e = 3; e >= 0; --e) {
                    const int i = 4 * g + e, key = kbase + e + 8 * g;
                    const float w = __expf(z[i] - a[i] - run);
                    p[i] = key < qrow ? w : 0.f;
                    run += a[i];
                }
                suf += bs[g] + pbs[g];
            }
            carry += suf;
#pragma unroll
            for (int s2 = 0; s2 < 2; ++s2) {
                u32x4 pw; pw.x = pack_bf2(p[8 * s2 + 0], p[8 * s2 + 1]); pw.y = pack_bf2(p[8 * s2 + 2], p[8 * s2 + 3]); pw.z = pack_bf2(p[8 * s2 + 4], p[8 * s2 + 5]); pw.w = pack_bf2(p[8 * s2 + 6], p[8 * s2 + 7]);
                const bf16x8 pf = __builtin_bit_cast(bf16x8, pw);
                const int kcol = (sub * 2 + s2) * 16 + hh * 8;
                const bf16x8 v0 = *(const LAS bf16x8*)(Vs + r * KP + kcol);
                const bf16x8 v1 = *(const LAS bf16x8*)(Vs + (32 + r) * KP + kcol);
                o0 = __builtin_amdgcn_mfma_f32_32x32x16_bf16(v0, pf, o0, 0, 0, 0);
                o1 = __builtin_amdgcn_mfma_f32_32x32x16_bf16(v1, pf, o1, 0, 0, 0);
            }
        }
    }
    u16* orow = mixed + tokq * D_ + h * 64;
#pragma unroll
    for (int g = 0; g < 4; ++g) {
        u32x2 w0, w1;
        w0.x = pack_bf2(o0[4 * g], o0[4 * g + 1]); w0.y = pack_bf2(o0[4 * g + 2], o0[4 * g + 3]);
        w1.x = pack_bf2(o1[4 * g], o1[4 * g + 1]); w1.y = pack_bf2(o1[4 * g + 2], o1[4 * g + 3]);
        *(u32x2*)(orow + 8 * g + 4 * hh) = w0;
        *(u32x2*)(orow + 32 + 8 * g + 4 * hh) = w1;
    }
}

DI void sgu_unit(const u16* zt, const u16* wm, const float* bs, const u16* proj, u16* mixed, int b, int n, int g) {
    const int tid = threadIdx.x, lane = tid & 63, wave = tid >> 6, r = lane & 31, hh = lane >> 5;
    const int dt = wave & 1, it = wave >> 1;
    const u16* zrow = zt + ((size_t)(b * 8 + g) * 64 + dt * 32 + r) * S_ + n * 128;
    const u16* wrow = wm + ((size_t)g * 128 + it * 32 + r) * 128;
    f32x16 c;
#pragma unroll
    for (int i = 0; i < 16; ++i) c[i] = 0.f;
#pragma unroll
    for (int kk = 0; kk < 8; ++kk) {
        const bf16x8 af = *(const bf16x8*)(zrow + kk * 16 + hh * 8);
        const bf16x8 bf = *(const bf16x8*)(wrow + kk * 16 + hh * 8);
        c = __builtin_amdgcn_mfma_f32_32x32x16_bf16(af, bf, c, 0, 0, 0);
    }
    const int i_loc = it * 32 + r;
    const size_t tok = (size_t)b * S_ + n * 128 + i_loc;
    const float bias = bs[g * 128 + i_loc];
#pragma unroll
    for (int q = 0; q < 4; ++q) {
        const int d = dt * 32 + 8 * q + 4 * hh;
        const u32x2 uw = *(const u32x2*)(proj + tok * AB_COLS + 1536 + g * 64 + d);
        u32x2 w;
        w.x = pack_bf2(bf_lo(uw.x) * (c[4 * q] + bias), bf_hi(uw.x) * (c[4 * q + 1] + bias));
        w.y = pack_bf2(bf_lo(uw.y) * (c[4 * q + 2] + bias), bf_hi(uw.y) * (c[4 * q + 3] + bias));
        *(u32x2*)(mixed + tok * D_ + 512 + g * 64 + d) = w;
    }
}


DI void router_phase(LAS unsigned char* lds, const float* h, const float* gain, const float* wg, const float* bg, const float* we, const float* be,
                     u16* xn, int* tok_e, float* tok_c, int* cnt) {
    const int tid = threadIdx.x, lane = tid & 63, wave = tid >> 6;
    LAS int* lcnt = (LAS int*)(lds + LDS_TAB);
    f32x4 gv[4];
#pragma unroll
    for (int i = 0; i < 4; ++i) gv[i] = *(const f32x4*)(gain + lane * 4 + 256 * i);
    for (int unit = blockIdx.x; unit < T_ / 64; unit += gridDim.x) {
        if (tid < 16) lcnt[tid] = 0;
        __syncthreads();
        for (int tl = 0; tl < 8; ++tl) {
            const int row = unit * 64 + wave * 8 + tl;
            const float* p = h + (size_t)row * D_;
            f32x4 v[4]; float ss = 0.f;
#pragma unroll
            for (int i = 0; i < 4; ++i) { v[i] = *(const f32x4*)(p + lane * 4 + 256 * i); ss += v[i][0] * v[i][0] + v[i][1] * v[i][1] + v[i][2] * v[i][2] + v[i][3] * v[i][3]; }
            ss = wave_sum(ss);
            const float r = rsqrtf(ss * (1.f / D_) + EPS);
            float gl[4] = {0.f, 0.f, 0.f, 0.f};
#pragma unroll
            for (int i = 0; i < 4; ++i) {
#pragma unroll
                for (int j = 0; j < 4; ++j) v[i][j] = v[i][j] * r * gv[i][j];
                u32x2 w; w.x = pack_bf2(v[i][0], v[i][1]); w.y = pack_bf2(v[i][2], v[i][3]);
                *(u32x2*)(xn + (size_t)row * D_ + lane * 4 + 256 * i) = w;
#pragma unroll
                for (int j = 0; j < 4; ++j) { const f32x4 wv = *(const f32x4*)(wg + (size_t)(lane * 4 + 256 * i + j) * 4);
                    gl[0] += v[i][j] * wv[0]; gl[1] += v[i][j] * wv[1]; gl[2] += v[i][j] * wv[2]; gl[3] += v[i][j] * wv[3]; }
            }
#pragma unroll
            for (int k = 0; k < 4; ++k) gl[k] = wave_sum(gl[k]) + bg[k];
            int gs = 0; float gm = gl[0];
#pragma unroll
            for (int k = 1; k < 4; ++k) if (gl[k] > gm) { gm = gl[k]; gs = k; }
            float gden = 0.f;
#pragma unroll
            for (int k = 0; k < 4; ++k) gden += __expf(gl[k] - gm);
            const float pgroup = 1.f / gden;
            gs = __builtin_amdgcn_readfirstlane(gs);
            const float* wep = we + (size_t)gs * 1024 * 4;
            float el[4] = {0.f, 0.f, 0.f, 0.f};
#pragma unroll
            for (int i = 0; i < 4; ++i)
#pragma unroll
                for (int j = 0; j < 4; ++j) { const f32x4 wv = *(const f32x4*)(wep + (size_t)(lane * 4 + 256 * i + j) * 4);
                    el[0] += v[i][j] * wv[0]; el[1] += v[i][j] * wv[1]; el[2] += v[i][j] * wv[2]; el[3] += v[i][j] * wv[3]; }
#pragma unroll
            for (int k = 0; k < 4; ++k) el[k] = wave_sum(el[k]) + be[gs * 4 + k];
            int i1 = 0; float m1 = el[0];
#pragma unroll
            for (int k = 1; k < 4; ++k) if (el[k] > m1) { m1 = el[k]; i1 = k; }
            int i2 = -1; float m2 = -3.0e38f;
#pragma unroll
            for (int k = 0; k < 4; ++k) if (k != i1 && el[k] > m2) { m2 = el[k]; i2 = k; }
            const float e2 = __expf(m2 - m1), inv = 1.f / (1.f + e2);
            if (lane == 0) {
                const int ea = gs * 4 + i1, eb = gs * 4 + i2;
                tok_e[row] = ea | (eb << 8);
                tok_c[row * 2] = pgroup * inv; tok_c[row * 2 + 1] = pgroup * e2 * inv;
                atomicAdd((int*)&lcnt[ea], 1); atomicAdd((int*)&lcnt[eb], 1);
            }
        }
        __syncthreads();
        if (tid < 16) cnt[unit * 16 + tid] = lcnt[tid];
        __syncthreads();
    }
}

DI void scatter_phase(LAS unsigned char* lds, const u16* xn, const int* tok_e, const int* cnt, int* tok_pos, int* seg_g, u16* xs) {
    const int tid = threadIdx.x, lane = tid & 63, wave = tid >> 6;
    LAS int* tot = (LAS int*)(lds + LDS_TAB);
    LAS int* mine = tot + 16;
    LAS int* seg = tot + 32;
    LAS int* lpos = tot + 64;
    for (int unit = blockIdx.x; unit < T_ / 64; unit += gridDim.x) {
        if (tid < 16) { int t = 0, m = 0; for (int u = 0; u < T_ / 64; ++u) { const int c = cnt[u * 16 + tid]; if (u == unit) m = t; t += c; } tot[tid] = t; mine[tid] = m; }
        __syncthreads();
        if (tid == 0) { int s = 0; for (int e = 0; e < 16; ++e) { seg[e] = s; s += (tot[e] + 255) & ~255; } seg[16] = s;
            if (unit == 0) for (int e = 0; e <= 16; ++e) seg_g[e] = seg[e]; }
        __syncthreads();
        if (wave == 0) {
            const int ee = tok_e[unit * 64 + lane], e0 = ee & 255, e1 = ee >> 8;
            const unsigned long long lt = (1ull << lane) - 1ull;
            int p0 = 0, p1 = 0;
#pragma unroll
            for (int ex = 0; ex < 16; ++ex) {
                const unsigned long long m0 = __ballot(e0 == ex), m1 = __ballot(e1 == ex);
                const int base = seg[ex] + mine[ex];
                if (e0 == ex) p0 = base + __popcll(m0 & lt);
                if (e1 == ex) p1 = base + __popcll(m0) + __popcll(m1 & lt);
            }
            tok_pos[(unit * 64 + lane) * 2] = p0; tok_pos[(unit * 64 + lane) * 2 + 1] = p1;
            lpos[lane * 2] = p0; lpos[lane * 2 + 1] = p1;
        }
        __syncthreads();
        for (int tl = wave * 8; tl < wave * 8 + 8; ++tl) {
            const u16* srow = xn + (size_t)(unit * 64 + tl) * D_;
            const u32x4 a = *(const u32x4*)(srow + lane * 8), b = *(const u32x4*)(srow + 512 + lane * 8);
#pragma unroll
            for (int k = 0; k < 2; ++k) { u16* drow = xs + (size_t)lpos[tl * 2 + k] * D_; *(u32x4*)(drow + lane * 8) = a; *(u32x4*)(drow + 512 + lane * 8) = b; }
        }
        __syncthreads();
    }
}

DI void combine_phase(float* h, const u16* yb, const int* tok_pos, const float* tok_c, const float* gain, u16* xn) {
    const int lane = threadIdx.x & 63, wave = threadIdx.x >> 6;
    for (int row = blockIdx.x * 8 + wave; row < T_; row += gridDim.x * 8) {
        float* p = h + (size_t)row * D_;
        const int p0 = tok_pos[row * 2], p1 = tok_pos[row * 2 + 1];
        const float c0 = tok_c[row * 2], c1 = tok_c[row * 2 + 1];
        f32x4 v[4]; float ss = 0.f;
#pragma unroll
        for (int i = 0; i < 4; ++i) {
            v[i] = *(const f32x4*)(p + lane * 4 + 256 * i);
            const u32x2 a = *(const u32x2*)(yb + (size_t)p0 * D_ + lane * 4 + 256 * i), b = *(const u32x2*)(yb + (size_t)p1 * D_ + lane * 4 + 256 * i);
            v[i][0] += c0 * bf_lo(a.x) + c1 * bf_lo(b.x); v[i][1] += c0 * bf_hi(a.x) + c1 * bf_hi(b.x);
            v[i][2] += c0 * bf_lo(a.y) + c1 * bf_lo(b.y); v[i][3] += c0 * bf_hi(a.y) + c1 * bf_hi(b.y);
            *(f32x4*)(p + lane * 4 + 256 * i) = v[i];
            ss += v[i][0] * v[i][0] + v[i][1] * v[i][1] + v[i][2] * v[i][2] + v[i][3] * v[i][3];
        }
        if (gain) {
            ss = wave_sum(ss);
            const float r = rsqrtf(ss * (1.f / D_) + EPS);
#pragma unroll
            for (int i = 0; i < 4; ++i) { const f32x4 gvv = *(const f32x4*)(gain + lane * 4 + 256 * i);
                u32x2 w; w.x = pack_bf2(v[i][0] * r * gvv[0], v[i][1] * r * gvv[1]); w.y = pack_bf2(v[i][2] * r * gvv[2], v[i][3] * r * gvv[3]);
                *(u32x2*)(xn + (size_t)row * D_ + lane * 4 + 256 * i) = w; }
        }
    }
}

DI void sincos_rev(int pos, double invf, float& c, float& s) {
    const double rev = (double)pos * invf * 0.15915494309189535;
    const float fr = (float)(rev - __builtin_rint(rev));
    s = __builtin_amdgcn_sinf(fr); c = __builtin_amdgcn_cosf(fr);
}
DI void unpack8(const u32x4 w, float (&f)[8]) { f[0] = bf_lo(w.x); f[1] = bf_hi(w.x); f[2] = bf_lo(w.y); f[3] = bf_hi(w.y); f[4] = bf_lo(w.z); f[5] = bf_hi(w.z); f[6] = bf_lo(w.w); f[7] = bf_hi(w.w); }
DI u32x4 pack8(const float (&f)[8]) { u32x4 w; w.x = pack_bf2(f[0], f[1]); w.y = pack_bf2(f[2], f[3]); w.z = pack_bf2(f[4], f[5]); w.w = pack_bf2(f[6], f[7]); return w; }
DI void transpose_write_v(const LAS u16* vtile, u16* dst, int tok0) {
    const int col = threadIdx.x, b = tok0 / S_, s0 = tok0 % S_;
    u16* vdst = dst + ((size_t)(b * 512 + col)) * S_ + s0;
#pragma unroll
    for (int c = 0; c < 8; ++c) {
        unsigned vw[4];
#pragma unroll
        for (int j = 0; j < 4; ++j) {
            const int p0 = c * 8 + 2 * j, p1 = p0 + 1;
            const int k0 = (p0 & ~15) + vperm16(p0 & 15), k1 = (p1 & ~15) + vperm16(p1 & 15);
            vw[j] = (unsigned)vtile[k0 * 512 + col] | ((unsigned)vtile[k1 * 512 + col] << 16);
        }
        *(u32x4*)(vdst + c * 8) = (u32x4){vw[0], vw[1], vw[2], vw[3]};
    }
}

DI void post_l1a(LAS unsigned char* lds, u16* proj1, const int* positions, const double* invf, const float* qlat_g, const float* kvlat_g, const float* kr_g, const float* dq_g, const float* dk_g,
                 u16* lat, u16* krope, u16* ikp, float* iwp, u16* vdt) {
    const int tid = threadIdx.x, lane = tid & 63, wave = tid >> 6;
    LAS u16* vtile = (LAS u16*)lds;
    for (int unit = blockIdx.x; unit < T_ / 64; unit += gridDim.x) {
        const int tok0 = unit * 64;
        for (int tl = wave * 8; tl < wave * 8 + 8; ++tl) {
            const int tok = tok0 + tl, pos = positions[tok];
            u16* row = proj1 + (size_t)tok * CD_PAD;
            {
                const int colA = lane < 32 ? lane * 8 : lane < 48 ? 256 + (lane - 32) * 8 : lane < 52 ? 384 + (lane - 48) * 8 : lane < 56 ? 2208 + (lane - 52) * 8 : lane == 56 ? 2240 : 0;
                float f[8]; unpack8(*(const u32x4*)(row + colA), f);
                float ss = 0.f;
#pragma unroll
                for (int j = 0; j < 8; ++j) ss += f[j] * f[j];
                ss += __shfl_xor(ss, 1); ss += __shfl_xor(ss, 2); const float ss4 = ss;
                ss += __shfl_xor(ss, 4); ss += __shfl_xor(ss, 8); const float ss16 = ss;
                ss += __shfl_xor(ss, 16); const float ss32 = ss;
                const int ksub = (lane - 48) & 3;
                float xk[8], pk[8];
                { const float r = rsqrtf(ss4 * (1.f / 32.f) + EPS);
#pragma unroll
                  for (int j = 0; j < 8; ++j) xk[j] = f[j] * r * kr_g[ksub * 8 + j]; }
#pragma unroll
                for (int j = 0; j < 8; ++j) pk[j] = __shfl_xor(xk[j], 2);
                if (lane < 32) {
                    const float r = rsqrtf(ss32 * (1.f / 256.f) + EPS); float o[8];
#pragma unroll
                    for (int j = 0; j < 8; ++j) o[j] = f[j] * r * qlat_g[lane * 8 + j];
                    *(u32x4*)(lat + (size_t)tok * 512 + lane * 8) = pack8(o);
                } else if (lane < 48) {
                    const float r = rsqrtf(ss16 * (1.f / 128.f) + EPS); float o[8];
#pragma unroll
                    for (int j = 0; j < 8; ++j) o[j] = f[j] * r * kvlat_g[(lane - 32) * 8 + j];
                    *(u32x4*)(lat + (size_t)tok * 512 + 256 + (lane - 32) * 8) = pack8(o);
                } else if (lane < 52) {
                    float o[8];
#pragma unroll
                    for (int j = 0; j < 8; ++j) { float c, s; sincos_rev(pos, invf[(ksub & 1) * 8 + j], c, s); o[j] = ksub < 2 ? xk[j] * c - pk[j] * s : xk[j] * c + pk[j] * s; }
                    *(u32x4*)(krope + (size_t)tok * 32 + ksub * 8) = pack8(o);
                } else if (lane < 56) {
                    float o[8];
#pragma unroll
                    for (int j = 0; j < 8; ++j) o[j] = f[j];
                    if (lane == 52) {
#pragma unroll
                        for (int j = 0; j < 4; ++j) { float c, s; sincos_rev(pos, invf[24 + j], c, s); o[j] = f[j] * c - f[j + 4] * s; o[j + 4] = f[j + 4] * c + f[j] * s; } }
                    *(u32x4*)(ikp + (size_t)tok * 32 + (lane - 52) * 8) = pack8(o);
                } else if (lane == 56) {
#pragma unroll
                    for (int j = 0; j < 8; ++j) iwp[(size_t)tok * 8 + j] = f[j] * 0.0625f;
                }
                if (lane >= 48) *(u32x4*)(lat + (size_t)tok * 512 + 384 + (lane - 48) * 8) = (u32x4){0u, 0u, 0u, 0u};
            }
            {
                const int sub = lane & 7;
                float c16[8], s16[8];
#pragma unroll
                for (int j = 0; j < 8; ++j) sincos_rev(pos, invf[16 + j], c16[j], s16[j]);
#pragma unroll
                for (int i = 0; i < 2; ++i) {
                    u16* p = row + 416 + i * 512 + lane * 8;
                    float f[8]; unpack8(*(const u32x4*)p, f);
                    float ss = 0.f;
#pragma unroll
                    for (int j = 0; j < 8; ++j) ss += f[j] * f[j];
                    ss += __shfl_xor(ss, 1); ss += __shfl_xor(ss, 2); ss += __shfl_xor(ss, 4);
                    const float r = rsqrtf(ss * (1.f / 64.f) + EPS);
                    const float* gp = (i == 0 ? dq_g : dk_g) + sub * 8;
                    float x[8], px[8], o[8];
#pragma unroll
                    for (int j = 0; j < 8; ++j) x[j] = f[j] * r * gp[j];
#pragma unroll
                    for (int j = 0; j < 8; ++j) px[j] = __shfl_xor(x[j], 1);
#pragma unroll
                    for (int j = 0; j < 8; ++j) o[j] = sub == 0 ? x[j] * c16[j] - px[j] * s16[j] : sub == 1 ? x[j] * c16[j] + px[j] * s16[j] : x[j];
                    *(u32x4*)p = pack8(o);
                }
            }
            { const u32x4 w = *(const u32x4*)(row + 1440 + lane * 8); *(LAS u32x4*)(vtile + tl * 512 + lane * 8) = w; }
            if (lane < 32 && (lane & 3) == 0) {
                u16* p = row + 1952 + lane * 8;
                float f[8], o[8]; unpack8(*(const u32x4*)p, f);
#pragma unroll
                for (int j = 0; j < 4; ++j) { float c, s; sincos_rev(pos, invf[24 + j], c, s); o[j] = f[j] * c - f[j + 4] * s; o[j + 4] = f[j + 4] * c + f[j] * s; }
                *(u32x4*)p = pack8(o);
            }
        }
        __syncthreads();
        transpose_write_v(vtile, vdt, tok0);
        __syncthreads();
    }
}

DI void post_l1b(LAS unsigned char* lds, u16* kvr, const float* kn_g, u16* vct) {
    const int tid = threadIdx.x, lane = tid & 63, wave = tid >> 6;
    LAS u16* vtile = (LAS u16*)lds;
    for (int unit = blockIdx.x; unit < T_ / 64; unit += gridDim.x) {
        const int tok0 = unit * 64;
        for (int tl = wave * 8; tl < wave * 8 + 8; ++tl) {
            u16* row = kvr + (size_t)(tok0 + tl) * 1024;
#pragma unroll
            for (int i = 0; i < 2; ++i) {
                const int chunk = lane + 64 * i, head = chunk >> 4, sub = chunk & 15;
                const u32x4 w = *(const u32x4*)(row + chunk * 8);
                float f[8]; unpack8(w, f);
                float ss = 0.f;
#pragma unroll
                for (int j = 0; j < 8; ++j) ss += f[j] * f[j];
                ss += __shfl_xor(ss, 1); ss += __shfl_xor(ss, 2); ss += __shfl_xor(ss, 4);
                if (sub < 8) {
                    const float r = rsqrtf(ss * (1.f / 64.f) + EPS); float o[8];
#pragma unroll
                    for (int j = 0; j < 8; ++j) o[j] = f[j] * r * kn_g[sub * 8 + j];
                    *(u32x4*)(row + chunk * 8) = pack8(o);
                } else {
                    *(LAS u32x4*)(vtile + tl * 512 + head * 64 + (sub - 8) * 8) = w;
                }
            }
        }
        __syncthreads();
        transpose_write_v(vtile, vct, tok0);
        __syncthreads();
    }
}

DI unsigned fkey(float f) { const unsigned u = __float_as_uint(f); return (u & 0x80000000u) ? ~u : (u | 0x80000000u); }
DI void idx_scores(const u16* ikp, size_t tokk, int hh, const bf16x8 a0, const bf16x8 a1, const float (&wa)[8], const float (&wb)[8], float& sa, float& sb) {
    const bf16x8 b0 = *(const bf16x8*)(ikp + tokk * 32 + hh * 8), b1 = *(const bf16x8*)(ikp + tokk * 32 + 16 + hh * 8);
    f32x16 c;
#pragma unroll
    for (int i = 0; i < 16; ++i) c[i] = 0.f;
    c = __builtin_amdgcn_mfma_f32_32x32x16_bf16(a0, b0, c, 0, 0, 0);
    c = __builtin_amdgcn_mfma_f32_32x32x16_bf16(a1, b1, c, 0, 0, 0);
    sa = 0.f; sb = 0.f;
#pragma unroll
    for (int h = 0; h < 8; ++h) { sa = __builtin_fmaf(wa[h], fmaxf(c[h], 0.f), sa); sb = __builtin_fmaf(wb[h], fmaxf(c[8 + h], 0.f), sb); }
}
template <int NPASS>
DI void indexer_unit(LAS unsigned char* lds, const u16* proj1, const u16* ikp, const float* iwp, unsigned* mask, int b, int j32) {
    const int tid = threadIdx.x, lane = tid & 63, wave = __builtin_amdgcn_readfirstlane(tid >> 6), r = lane & 31, hh = lane >> 5;
    LAS unsigned* hist = (LAS unsigned*)lds + wave * 1024;
    const int s0 = j32 * 32 + wave * 4;
    const int NT = 2 * ((j32 >> 1) + 1);
    const size_t tokb = (size_t)b * S_;
    if (NT <= 8) {
        if (lane < 4) for (int t = 0; t < NT; ++t) mask[(tokb + s0 + lane) * 128 + t] = 0xffffffffu;
        return;
    }
    bf16x8 a0, a1;
    { const int g = r >> 3, hr = (r >> 2) & 1, i = r & 3, qA = 2 * hr + (g >> 1), head = 4 * (g & 1) + i;
      const u16* p = proj1 + (tokb + s0 + qA) * CD_PAD + 1952 + head * 32 + hh * 8;
      a0 = *(const bf16x8*)p; a1 = *(const bf16x8*)(p + 16); }
    float wa[8], wb[8];
#pragma unroll
    for (int h = 0; h < 8; ++h) { wa[h] = iwp[(tokb + s0 + 2 * hh) * 8 + h]; wb[h] = iwp[(tokb + s0 + 2 * hh + 1) * 8 + h]; }
    unsigned pre0 = 0u, pre1 = 0u, pre2 = 0u, pre3 = 0u; int kr0 = 256, kr1 = 256, kr2 = 256, kr3 = 256;
#pragma unroll
    for (int pass = 0; pass < NPASS; ++pass) {
        const int shift = 24 - 8 * pass;
        __syncthreads();
#pragma unroll
        for (int i = 0; i < 16; ++i) hist[lane + 64 * i] = 0u;
        __syncthreads();
        const unsigned pa = hh ? pre2 : pre0, pb = hh ? pre3 : pre1;
        for (int t = 0; t < NT; ++t) {
            float sa, sb; idx_scores(ikp, tokb + t * 32 + r, hh, a0, a1, wa, wb, sa, sb);
            const unsigned ka = fkey(sa), kb = fkey(sb);
            if (pass == 0 || (ka >> ((shift + 8) & 31)) == pa) atomicAdd((unsigned*)&hist[(2 * hh) * 256 + ((ka >> shift) & 255u)], 1u);
            if (pass == 0 || (kb >> ((shift + 8) & 31)) == pb) atomicAdd((unsigned*)&hist[(2 * hh + 1) * 256 + ((kb >> shift) & 255u)], 1u);
        }
        __syncthreads();
#pragma unroll
        for (int q = 0; q < 4; ++q) {
            const u32x4 c4 = *(const LAS u32x4*)(hist + q * 256 + lane * 4);
            const int s = (int)(c4.x + c4.y + c4.z + c4.w);
            int Ssum = s;
#pragma unroll
            for (int o = 1; o < 64; o <<= 1) { const int tv = __shfl_down(Ssum, o); if (lane + o < 64) Ssum += tv; }
            const int kr = q == 0 ? kr0 : q == 1 ? kr1 : q == 2 ? kr2 : kr3;
            const unsigned long long bal = __ballot(Ssum >= kr);
            const int ls = 63 - __builtin_clzll(bal | 1ull);
            int cum = Ssum - s, bin = 0, newk = 1;
            { bool found = false;
              const unsigned cc[4] = {c4.x, c4.y, c4.z, c4.w};
#pragma unroll
              for (int bb = 3; bb >= 0; --bb) { if (!found && cum + (int)cc[bb] >= kr) { bin = lane * 4 + bb; newk = kr - cum; found = true; } if (!found) cum += (int)cc[bb]; } }
            bin = __builtin_amdgcn_readlane(bin, ls); newk = __builtin_amdgcn_readlane(newk, ls);
            if (q == 0) { pre0 = (pre0 << 8) | (unsigned)bin; kr0 = newk; } else if (q == 1) { pre1 = (pre1 << 8) | (unsigned)bin; kr1 = newk; }
            else if (q == 2) { pre2 = (pre2 << 8) | (unsigned)bin; kr2 = newk; } else { pre3 = (pre3 << 8) | (unsigned)bin; kr3 = newk; }
        }
    }
    {
        const unsigned pa = hh ? pre2 : pre0, pb = hh ? pre3 : pre1;
        constexpr int fs = 32 - 8 * NPASS;
        for (int t = 0; t < NT; ++t) {
            float sa, sb; idx_scores(ikp, tokb + t * 32 + r, hh, a0, a1, wa, wb, sa, sb);
            const unsigned ka = fs ? (fkey(sa) >> (fs & 31)) : fkey(sa), kb = fs ? (fkey(sb) >> (fs & 31)) : fkey(sb);
            const unsigned long long ga = __ballot(ka > pa), ta = __ballot(ka == pa), gb = __ballot(kb > pb), tb = __ballot(kb == pb);
            unsigned w[4] = {(unsigned)ga, (unsigned)gb, (unsigned)(ga >> 32), (unsigned)(gb >> 32)};
            const unsigned tw[4] = {(unsigned)ta, (unsigned)tb, (unsigned)(ta >> 32), (unsigned)(tb >> 32)};
#pragma unroll
            for (int q = 0; q < 4; ++q) {
                int kr = q == 0 ? kr0 : q == 1 ? kr1 : q == 2 ? kr2 : kr3;
                if (tw[q]) {
                    const int n = __popc(tw[q]);
                    if (n <= kr) { w[q] |= tw[q]; kr -= n; }
                    else { unsigned acc = 0u, tt = tw[q]; for (int k = 0; k < kr; ++k) { acc |= tt & (0u - tt); tt &= tt - 1u; } w[q] |= acc; kr = 0; }
                    if (q == 0) kr0 = kr; else if (q == 1) kr1 = kr; else if (q == 2) kr2 = kr; else kr3 = kr;
                }
            }
            if (lane < 4) mask[(tokb + s0 + lane) * 128 + t] = lane == 0 ? w[0] : lane == 1 ? w[1] : lane == 2 ? w[2] : w[3];
        }
    }
}

template <bool MLA>
DI void sm_attn_unit(LAS unsigned char* lds, const u16* qsrc, const u16* ksrc, const u16* krope, const u16* vt, const unsigned* mask, const int* positions, const double* invf, const float* qg,
                     u16* mixed, int b, int h, int qb) {
    constexpr int DK = MLA ? 96 : 64, NKK = DK / 16, KPI = DK + 8;
    const int tid = threadIdx.x, lane = tid & 63, wave = __builtin_amdgcn_readfirstlane(tid >> 6), r = lane & 31, hh = lane >> 5;
    LAS u16* Ks = (LAS u16*)lds;
    LAS u16* Vs = (LAS u16*)(lds + 64 * KPI * 2);
    const int q0 = qb * 256, qrow = q0 + wave * 32 + r;
    const size_t tokb = (size_t)b * S_, tokq = tokb + qrow;
    bf16x8 qf[NKK];
    if constexpr (MLA) {
        float f[NKK][8]; float ss = 0.f;
#pragma unroll
        for (int kk = 0; kk < NKK; ++kk) { unpack8(*(const u32x4*)(qsrc + tokq * 768 + h * 96 + kk * 16 + hh * 8), f[kk]);
#pragma unroll
            for (int j = 0; j < 8; ++j) ss += f[kk][j] * f[kk][j]; }
        ss += __shfl_xor(ss, 32);
        const float rr = rsqrtf(ss * (1.f / 96.f) + EPS);
#pragma unroll
        for (int kk = 0; kk < NKK; ++kk)
#pragma unroll
            for (int j = 0; j < 8; ++j) f[kk][j] = f[kk][j] * rr * qg[kk * 16 + hh * 8 + j];
        const int pos = positions[tokq];
#pragma unroll
        for (int j = 0; j < 8; ++j) { float c, s; sincos_rev(pos, invf[hh * 8 + j], c, s); const float x1 = f[0][j], x2 = f[1][j]; f[0][j] = x1 * c - x2 * s; f[1][j] = x2 * c + x1 * s; }
#pragma unroll
        for (int kk = 0; kk < NKK; ++kk) qf[kk] = __builtin_bit_cast(bf16x8, pack8(f[kk]));
    } else {
#pragma unroll
        for (int kk = 0; kk < NKK; ++kk) qf[kk] = *(const bf16x8*)(qsrc + tokq * CD_PAD + 416 + h * 64 + kk * 16 + hh * 8);
    }
    const float sc2 = (MLA ? 0.10206207261596575f : 0.125f) * 1.4426950408889634f;
    f32x16 o0, o1;
#pragma unroll
    for (int i = 0; i < 16; ++i) { o0[i] = 0.f; o1[i] = 0.f; }
    float m = -1.0e30f, l = 0.f;
    const int kt_end = qb * 4 + (wave >> 1);
    for (int kt = 0; kt <= qb * 4 + 3; ++kt) {
        __syncthreads();
        if constexpr (MLA) {
#pragma unroll
            for (int i = 0; i < 2; ++i) { const int c = tid + i * 512;
                if (c < 768) { const int key = c / 12, cc = c % 12; const size_t tk = tokb + kt * 64 + key;
                    const u32x4 w = cc < 4 ? *(const u32x4*)(krope + tk * 32 + cc * 8) : *(const u32x4*)(ksrc + tk * 1024 + h * 128 + (cc - 4) * 8);
                    *(LAS u32x4*)(Ks + key * KPI + cc * 8) = w; } }
        } else {
            const int key = tid >> 3, c8 = (tid & 7) * 8;
            *(LAS u32x4*)(Ks + key * KPI + c8) = *(const u32x4*)(ksrc + (tokb + kt * 64 + key) * CD_PAD + 928 + h * 64 + c8);
        }
        { const int row = tid >> 3, c8 = (tid & 7) * 8;
          *(LAS u32x4*)(Vs + row * KP + c8) = *(const u32x4*)(vt + ((size_t)(b * 8 + h) * 64 + row) * S_ + kt * 64 + c8); }
        __syncthreads();
        if (kt > kt_end) continue;
        u32x2 mw = (u32x2){0xffffffffu, 0xffffffffu};
        if constexpr (!MLA) mw = *(const u32x2*)(mask + tokq * 128 + 2 * kt);
        f32x16 s[2];
#pragma unroll
        for (int sub = 0; sub < 2; ++sub) {
#pragma unroll
            for (int i = 0; i < 16; ++i) s[sub][i] = 0.f;
#pragma unroll
            for (int kk = 0; kk < NKK; ++kk) {
                const bf16x8 kf = *(const LAS bf16x8*)(Ks + (sub * 32 + r) * KPI + kk * 16 + hh * 8);
                s[sub] = __builtin_amdgcn_mfma_f32_32x32x16_bf16(kf, qf[kk], s[sub], 0, 0, 0);
            }
        }
        float mx = -1.0e30f;
#pragma unroll
        for (int sub = 0; sub < 2; ++sub)
#pragma unroll
            for (int i = 0; i < 16; ++i) {
                float v = s[sub][i] * sc2;
                if constexpr (!MLA) { const int bit = (i & 3) + 8 * (i >> 2) + 4 * hh; if (!(((sub ? mw.y : mw.x) >> bit) & 1u)) v = -1.0e30f; }
                s[sub][i] = v; mx = fmaxf(mx, v);
            }
        mx = fmaxf(mx, __shfl_xor(mx, 32));
        const float mnew = fmaxf(m, mx), alpha = __builtin_amdgcn_exp2f(m - mnew);
        m = mnew;
        float ls = 0.f;
#pragma unroll
        for (int sub = 0; sub < 2; ++sub)
#pragma unroll
            for (int i = 0; i < 16; ++i) { const float v = s[sub][i]; const float p = (v <= -1.0e30f) ? 0.f : __builtin_amdgcn_exp2f(v - mnew); s[sub][i] = p; ls += p; }
        l = l * alpha + ls;
#pragma unroll
        for (int i = 0; i < 16; ++i) { o0[i] *= alpha; o1[i] *= alpha; }
#pragma unroll
        for (int sub = 0; sub < 2; ++sub)
#pragma unroll
            for (int s2 = 0; s2 < 2; ++s2) {
                u32x4 pw; pw.x = pack_bf2(s[sub][8 * s2 + 0], s[sub][8 * s2 + 1]); pw.y = pack_bf2(s[sub][8 * s2 + 2], s[sub][8 * s2 + 3]);
                pw.z = pack_bf2(s[sub][8 * s2 + 4], s[sub][8 * s2 + 5]); pw.w = pack_bf2(s[sub][8 * s2 + 6], s[sub][8 * s2 + 7]);
                const bf16x8 pf = __builtin_bit_cast(bf16x8, pw);
                const int kcol = (sub * 2 + s2) * 16 + hh * 8;
                const bf16x8 v0 = *(const LAS bf16x8*)(Vs + r * KP + kcol);
                const bf16x8 v1 = *(const LAS bf16x8*)(Vs + (32 + r) * KP + kcol);
                o0 = __builtin_amdgcn_mfma_f32_32x32x16_bf16(v0, pf, o0, 0, 0, 0);
                o1 = __builtin_amdgcn_mfma_f32_32x32x16_bf16(v1, pf, o1, 0, 0, 0);
            }
    }
    l += __shfl_xor(l, 32);
    const float inv = 1.f / l;
    u16* orow = mixed + tokq * D_ + (MLA ? 0 : 512) + h * 64;
#pragma unroll
    for (int g = 0; g < 4; ++g) {
        u32x2 w0, w1;
        w0.x = pack_bf2(o0[4 * g] * inv, o0[4 * g + 1] * inv); w0.y = pack_bf2(o0[4 * g + 2] * inv, o0[4 * g + 3] * inv);
        w1.x = pack_bf2(o1[4 * g] * inv, o1[4 * g + 1] * inv); w1.y = pack_bf2(o1[4 * g + 2] * inv, o1[4 * g + 3] * inv);
        *(u32x2*)(orow + 8 * g + 4 * hh) = w0;
        *(u32x2*)(orow + 32 + 8 * g + 4 * hh) = w1;
    }
}

#define MOE_LAYER(base, layer) \
    if (IN(base)) { \
        int cb = 0; \
        for (int e = 0; e < 16; ++e) { \
            cb = cvt_matrix(lds, cb, P.in[27] + ((size_t)(layer) * 16 + e) * 1024 * 512, 1024, 512, 512, W_gu + (size_t)e * 1024 * 1024, 1024, 1); \
            cb = cvt_matrix(lds, cb, P.in[28] + ((size_t)(layer) * 16 + e) * 1024 * 512, 1024, 512, 512, W_gu + (size_t)e * 1024 * 1024, 1024, 2); \
            cb = cvt_matrix(lds, cb, P.in[29] + ((size_t)(layer) * 16 + e) * 512 * 1024, 512, 1024, 1024, W_dn + (size_t)e * 1024 * 512, 512, 0); } \
        router_phase(lds, P.out, P.in[22] + (layer) * 1024, P.in[23] + (layer) * 4096, P.in[24] + (layer) * 4, P.in[25] + (layer) * 16384, P.in[26] + (layer) * 16, XN, TOK_E, TOK_C, CNT); \
    } \
    SEAM(base); \
    if (IN((base) + 1)) scatter_phase(lds, XN, TOK_E, CNT, TOK_POS, SEG, XS); \
    SEAM((base) + 1); \
    if (IN((base) + 2)) { \
        LAS int* segl = (LAS int*)(lds + LDS_TAB + 128); if (tid < 17) segl[tid] = SEG[tid]; __syncthreads(); \
        pg8::Gemm g{XS, W_gu, 1024, 1024, 1024}; pg8::MoeOrder S{segl, (int)gridDim.x, vcu}; pg8::EpiGU E{HID}; \
        pg8::gemm_phase(lds, g, S, E); \
    } \
    SEAM((base) + 2); \
    if (IN((base) + 3)) { \
        LAS int* segl = (LAS int*)(lds + LDS_TAB + 128); if (tid < 17) segl[tid] = SEG[tid]; __syncthreads(); \
        pg8::Gemm g{HID, W_dn, 512, 512, 512}; pg8::MoeOrder S{segl, (int)gridDim.x, vcu}; pg8::EpiBf16 E{YB, 1024, 3}; \
        pg8::gemm_phase(lds, g, S, E); \
    } \
    SEAM((base) + 3);

__global__ void __launch_bounds__(512, 2) fwd(Params P) {
    extern __shared__ __attribute__((aligned(16))) unsigned char shm[];
    LAS unsigned char* lds = (LAS unsigned char*)shm;
    const int tid = threadIdx.x;
    if (tid == 0) { volatile LAS unsigned* st = (volatile LAS unsigned*)(lds + LDS_BARW); st[0] = 0u; st[1] = 0u; st[2] = 0u; st[3] = 0u; }
    __syncthreads();
    unsigned char* ws = P.ws;
    XcdBarrier bar = xcd_barrier_post((unsigned*)(ws + WS_CTL), (volatile LAS unsigned*)(lds + LDS_BARW));
    const int lo = P.ph_lo, hi = P.ph_hi;
#define IN(k) (lo <= (k) && (k) < hi)
#define SEAM(k) do { if (IN(k) && IN((k) + 1)) xcd_barrier(bar); } while (0)

    const float* x = P.in[0];
    u16* W_abin = (u16*)(ws + WS_WABIN); u16* W_about = (u16*)(ws + WS_WABOUT); u16* W_sgu = (u16*)(ws + WS_WSGU);
    u16* W_gu = (u16*)(ws + WS_WGU); u16* W_dn = (u16*)(ws + WS_WDN);
    u16* XS = (u16*)(ws + WS_R1); u16* HID = (u16*)(ws + WS_R2); u16* YB = (u16*)(ws + WS_R4);
    int* TOK_E = (int*)(ws + WS_MISC + MISC_TOKE); float* TOK_C = (float*)(ws + WS_MISC + MISC_TOKC); int* TOK_POS = (int*)(ws + WS_MISC + MISC_POS);
    int* CNT = (int*)(ws + WS_MISC + MISC_CNT); int* SEG = (int*)(ws + WS_MISC + MISC_SEG);
    const int vcu = (gridDim.x % 8 == 0) ? (int)((blockIdx.x % 8) * (gridDim.x / 8) + blockIdx.x / 8) : (int)blockIdx.x;
    u16* W_cdin = (u16*)(ws + WS_WCDIN); u16* W_uq = (u16*)(ws + WS_WUQ); u16* W_ukv = (u16*)(ws + WS_WUKV); u16* W_cdout = (u16*)(ws + WS_WCDOUT);
    u16* PROJ1 = (u16*)(ws + WS_PROJ1); unsigned* MASK = (unsigned*)(ws + WS_MASK); u16* KVR = (u16*)(ws + WS_KVR); u16* LAT = (u16*)(ws + WS_LAT); u16* QCR = (u16*)(ws + WS_QCR);
    u16* VCT = (u16*)(ws + WS_VCT); u16* VDT = (u16*)(ws + WS_VDT); u16* KROPE = (u16*)(ws + WS_MISC + MISC_KROPE); u16* IKP = (u16*)(ws + WS_MISC + MISC_IKP); float* IWP = (float*)(ws + WS_MISC + MISC_IWP);
    const int* positions = (const int*)P.in[1];
    u16* XN = (u16*)(ws + WS_XN); u16* PROJ = (u16*)(ws + WS_PROJ); u16* VT = (u16*)(ws + WS_VT); u16* ZT = (u16*)(ws + WS_ZT); u16* MIXED = (u16*)(ws + WS_MIXED);

    if (IN(0)) {
        int base = 0;
        base = cvt_matrix(lds, base, P.in[3], 1024, AB_COLS, AB_COLS, W_abin, 1024, 0);
        base = cvt_matrix(lds, base, P.in[9], 1024, 1024, 1024, W_about, 1024, 0);
        base = cvt_matrix(lds, base, P.in[11], 1024, CD_PAD, CD_COLS, W_cdin, 1024, 0);
        base = cvt_matrix(lds, base, P.in[14], 256, 768, 768, W_uq, 256, 0);
        base = cvt_matrix(lds, base, P.in[15], 128, 1024, 1024, W_ukv, 256, 0);
        base = cvt_matrix(lds, base, P.in[21], 1024, 1024, 1024, W_cdout, 1024, 0);
        for (int e = blockIdx.x * 512 + tid; e < 1024 * 16; e += gridDim.x * 512) *(u32x4*)(W_ukv + (size_t)(e >> 4) * 256 + 128 + (e & 15) * 8) = (u32x4){0u, 0u, 0u, 0u};
        for (int e = blockIdx.x * 512 + tid; e < 8 * 128 * 128 / 2; e += gridDim.x * 512) {
            const int j = (e * 2) & 127, i = ((e * 2) >> 7) & 127;
            const float a = P.in[7][e * 2], c = P.in[7][e * 2 + 1];
            const bool vis = (j >> 6) <= (i >> 6);
            ((unsigned*)W_sgu)[e] = vis ? pack_bf2(a, c) : 0u;
        }
        rmsnorm_rows(x, P.in[2], XN);
    }
    SEAM(0);
    if (IN(1)) {
        pg8::Gemm g{XN, W_abin, 1024, 1024, 1024}; pg8::StaticOrder S; S.init(T_, AB_COLS, gridDim.x, blockIdx.x);
        pg8::EpiBf16 E{PROJ, AB_COLS, 0x7fffffff};
        pg8::gemm_phase(lds, g, S, E);
    }
    SEAM(1);
    if (IN(2)) post_l0(lds, PROJ, P.in[4], P.in[5], P.in[6], VT, ZT);
    SEAM(2);
    if (IN(3)) {
        for (int p = blockIdx.x; p < 256; p += gridDim.x) {
            const int bh = p >> 3, pi = p & 7, b = bh >> 3, h = bh & 7;
            sb_attn_unit(lds, PROJ, VT, MIXED, b, h, 15 - pi);
            sb_attn_unit(lds, PROJ, VT, MIXED, b, h, pi);
        }
        for (int u = blockIdx.x; u < 1024; u += gridDim.x) {
            const int g = u & 7, n = (u >> 3) & 31, b = u >> 8;
            sgu_unit(ZT, W_sgu, P.in[8], PROJ, MIXED, b, n, g);
        }
    }
    SEAM(3);
    if (IN(4)) {
        pg8::Gemm g{MIXED, W_about, 1024, 1024, 1024}; pg8::StaticOrder S; S.init(T_, 1024, gridDim.x, blockIdx.x);
        pg8::EpiF32Res E{P.out, x, 1024};
        pg8::gemm_phase(lds, g, S, E);
    }
    SEAM(4);
    MOE_LAYER(5, 0)
    if (IN(9)) combine_phase(P.out, YB, TOK_POS, TOK_C, P.in[10], XN);
    SEAM(9);
    if (IN(10)) {
        pg8::Gemm g{XN, W_cdin, 1024, 1024, 1024}; pg8::StaticOrder S; S.init(T_, CD_PAD, gridDim.x, blockIdx.x);
        pg8::EpiBf16 E{PROJ1, CD_PAD, 0x7fffffff};
        pg8::gemm_phase(lds, g, S, E);
    }
    SEAM(10);
    if (IN(11)) post_l1a(lds, PROJ1, positions, P.invf, P.in[12], P.in[13], P.in[18], P.in[19], P.in[20], LAT, KROPE, IKP, IWP, VDT);
    SEAM(11);
    if (IN(12)) {
        { pg8::Gemm g{LAT, W_uq, 512, 256, 256}; pg8::StaticOrder S; S.init(T_, 768, gridDim.x, blockIdx.x); pg8::EpiBf16 E{QCR, 768, 0x7fffffff}; pg8::gemm_phase(lds, g, S, E); }
        { pg8::Gemm g{LAT + 256, W_ukv, 512, 256, 256}; pg8::StaticOrder S; S.init(T_, 1024, gridDim.x, blockIdx.x); pg8::EpiBf16 E{KVR, 1024, 0x7fffffff}; pg8::gemm_phase(lds, g, S, E); }
    }
    SEAM(12);
    if (IN(13)) {
        post_l1b(lds, KVR, P.in[17], VCT);
        for (int p = blockIdx.x; p < 256; p += gridDim.x) {
            const int b = p >> 6, pj = p & 63;
            indexer_unit<3>(lds, PROJ1, IKP, IWP, MASK, b, 127 - pj);
            __syncthreads();
            indexer_unit<3>(lds, PROJ1, IKP, IWP, MASK, b, pj);
            __syncthreads();
        }
    }
    SEAM(13);
    if (IN(14)) {
        for (int p = blockIdx.x; p < 256; p += gridDim.x) {
            const int bh = p >> 3, pi = p & 7, b = bh >> 3, h = bh & 7;
            sm_attn_unit<true>(lds, QCR, KVR, KROPE, VCT, MASK, positions, P.invf, P.in[16], MIXED, b, h, 15 - pi);
            sm_attn_unit<true>(lds, QCR, KVR, KROPE, VCT, MASK, positions, P.invf, P.in[16], MIXED, b, h, pi);
            sm_attn_unit<false>(lds, PROJ1, PROJ1, KROPE, VDT, MASK, positions, P.invf, P.in[16], MIXED, b, h, 15 - pi);
            sm_attn_unit<false>(lds, PROJ1, PROJ1, KROPE, VDT, MASK, positions, P.invf, P.in[16], MIXED, b, h, pi);
        }
    }
    SEAM(14);
    if (IN(15)) {
        pg8::Gemm g{MIXED, W_cdout, 1024, 1024, 1024}; pg8::StaticOrder S; S.init(T_, 1024, gridDim.x, blockIdx.x);
        pg8::EpiF32Res E{P.out, P.out, 1024};
        pg8::gemm_phase(lds, g, S, E);
    }
    SEAM(15);
    MOE_LAYER(16, 1)
    if (IN(20)) combine_phase(P.out, YB, TOK_POS, TOK_C, nullptr, XN);
}

extern "C" void kernel_launch(void* const* d_in, const int* in_sizes, int n_in, void* d_out, int out_size, void* d_ws, size_t ws_size, hipStream_t stream) {
    static int grid = 0;
    if (grid == 0) {
        if (n_in != 30 || out_size != T_ * D_ || ws_size < WS_END) { fprintf(stderr, "kernel_launch: unexpected shapes (n_in %d out %d ws %zu need %zu)\n", n_in, out_size, ws_size, (size_t)WS_END); grid = -1; return; }
        int dev = 0, cus = 0;
        if (hipGetDevice(&dev) != hipSuccess || hipDeviceGetAttribute(&cus, hipDeviceAttributeMultiprocessorCount, dev) != hipSuccess) { grid = -1; return; }
        if (hipFuncSetAttribute((const void*)fwd, hipFuncAttributeMaxDynamicSharedMemorySize, LDS_BYTES) != hipSuccess) { fprintf(stderr, "kernel_launch: hipFuncSetAttribute failed\n"); grid = -1; return; }
        int per_cu = 0;
        if (hipOccupancyMaxActiveBlocksPerMultiprocessor(&per_cu, (const void*)fwd, 512, LDS_BYTES) != hipSuccess || per_cu < 1) fprintf(stderr, "kernel_launch: occupancy query says %d\n", per_cu);
        (void)hipGetLastError();
        grid = cus;
    }
    if (grid < 0) return;
    (void)hipMemsetAsync((char*)d_ws + WS_CTL, 0, CTL_BYTES, stream);
    Params p{};
    for (int i = 0; i < 30; ++i) p.in[i] = (const float*)d_in[i];
    p.out = (float*)d_out; p.ws = (unsigned char*)d_ws; p.ph_lo = 0; p.ph_hi = 21;
    for (int i = 0; i < 16; ++i) p.invf[i] = pow(500000.0, -(double)i * (2.0 / 32.0));
    for (int i = 0; i < 8; ++i) p.invf[16 + i] = pow(500000.0, -(double)i * (2.0 / 16.0));
    for (int i = 0; i < 4; ++i) p.invf[24 + i] = pow(500000.0, -(double)i * (2.0 / 8.0));
    hipLaunchKernelGGL(fwd, dim3(grid), dim3(512), LDS_BYTES, stream, p);
}
```

```cpp
#include <hip/hip_runtime.h>
#include <cstdio>
#include <cstdint>
#include <cmath>

#define DI __device__ __forceinline__
#define LAS __attribute__((address_space(3)))
typedef unsigned short u16;
typedef short bf16x8 __attribute__((ext_vector_type(8)));
typedef float f32x4 __attribute__((ext_vector_type(4)));
typedef float f32x16 __attribute__((ext_vector_type(16)));
typedef unsigned u32x4 __attribute__((ext_vector_type(4)));
typedef unsigned u32x2 __attribute__((ext_vector_type(2)));
typedef __bf16 bf16x2_t __attribute__((ext_vector_type(2)));
typedef float f32x2_t __attribute__((ext_vector_type(2)));

constexpr int T_ = 16384, D_ = 1024, B_ = 4, S_ = 4096;
constexpr int AB_COLS = 2560, CD_COLS = 2248, CD_PAD = 2304;
constexpr float EPS = 1e-6f;

constexpr size_t WS_CTL    = 0;
constexpr size_t CTL_BYTES = 65536;
constexpr size_t WS_WABIN  = WS_CTL + CTL_BYTES;
constexpr size_t WS_WABOUT = WS_WABIN + (size_t)2560 * 1024 * 2;
constexpr size_t WS_WCDIN  = WS_WABOUT + (size_t)1024 * 1024 * 2;
constexpr size_t WS_WUQ    = WS_WCDIN + (size_t)2304 * 1024 * 2;
constexpr size_t WS_WUKV   = WS_WUQ + (size_t)768 * 256 * 2;
constexpr size_t WS_WCDOUT = WS_WUKV + (size_t)1024 * 256 * 2;
constexpr size_t WS_WSGU   = WS_WCDOUT + (size_t)1024 * 1024 * 2;
constexpr size_t WS_EXP    = WS_WSGU + (size_t)8 * 128 * 128 * 2;
constexpr size_t WS_WGU    = WS_EXP;
constexpr size_t WS_WDN    = WS_EXP + (size_t)16 * 1024 * 1024 * 2;
constexpr size_t WS_MIXED  = WS_EXP;
constexpr size_t EXP_BYTES = (size_t)16 * 1024 * 1024 * 2 + (size_t)16 * 1024 * 512 * 2;
constexpr size_t WS_R1     = WS_EXP + EXP_BYTES;
constexpr size_t R1_BYTES  = (size_t)T_ * 2560 * 2;
constexpr size_t WS_R2     = WS_R1 + R1_BYTES;
constexpr size_t R2_BYTES  = (size_t)36864 * 512 * 2;
constexpr size_t WS_R4     = WS_R2 + R2_BYTES;
constexpr size_t R4_BYTES  = (size_t)36864 * 1024 * 2;
constexpr size_t WS_MISC   = WS_R4 + R4_BYTES;
constexpr size_t WS_END    = WS_MISC + (size_t)8 * 1024 * 1024;

constexpr size_t WS_PROJ = WS_R1, WS_XN = WS_R2, WS_VT = WS_R4, WS_ZT = WS_R4 + (size_t)T_ * 512 * 2;

constexpr size_t WS_PROJ1 = WS_R1, WS_MASK = WS_R1 + (size_t)T_ * 2304 * 2, WS_KVR = WS_R2;
constexpr size_t WS_LAT = WS_R4, WS_QCR = WS_R4 + (size_t)T_ * 512 * 2, WS_VCT = WS_QCR + (size_t)T_ * 768 * 2, WS_VDT = WS_VCT + (size_t)T_ * 512 * 2;
constexpr size_t MISC_KROPE = 1048576, MISC_IKP = 2097152, MISC_IWP = 3145728;
constexpr size_t MISC_TOKE = 0, MISC_TOKC = 65536, MISC_POS = 196608, MISC_CNT = 327680, MISC_SEG = 344064;
constexpr int LDS_TAB = 131072;
constexpr int LDS_BYTES = 147456;
constexpr int LDS_BARW  = LDS_BYTES - 16;

DI unsigned pack_bf2(float lo, float hi) { f32x2_t v = {lo, hi}; bf16x2_t r = __builtin_convertvector(v, bf16x2_t); return __builtin_bit_cast(unsigned, r); }
DI float bf_lo(unsigned u) { return __uint_as_float(u << 16); }
DI float bf_hi(unsigned u) { return __uint_as_float(u & 0xffff0000u); }
DI float wave_sum(float v) {
#pragma unroll
    for (int o = 32; o >= 1; o >>= 1) v += __shfl_xor(v, o);
    return v;
}
DI float xor32(float x, int hh) {
    const unsigned u = __float_as_uint(x);
    const auto rr = __builtin_amdgcn_permlane32_swap(u, u, false, false);
    return __uint_as_float(hh ? rr[0] : rr[1]);
}
DI float gelu_tanh(float x) {
    const float y = 0.7978845608028654f * (x + 0.044715f * x * x * x);
    const float e = __expf(2.f * y);
    const float th = 1.f - 2.f / (1.f + e);
    return 0.5f * x * (1.f + th);
}

#define XB_TMO      128
#define XB_XCNT(j)  (256  + 64 * (j))
#define XB_XSUB(j)  (1280 + 64 * (j))
#define XB_XGEN(j)  (2304 + 64 * (j))
#define XB_TOP      3328
#define XB_TOPGEN   3392
#define XCD_BAR_WORDS 3456
#define XB_SPIN_CAP (1u << 18)

__device__ __forceinline__ unsigned xb_ld(unsigned* p)              { return __hip_atomic_load(p, __ATOMIC_RELAXED, __HIP_MEMORY_SCOPE_AGENT); }
__device__ __forceinline__ unsigned xb_add(unsigned* p, unsigned v) { return __hip_atomic_fetch_add(p, v, __ATOMIC_RELAXED, __HIP_MEMORY_SCOPE_AGENT); }
__device__ __forceinline__ unsigned xb_xcc_id() { return (unsigned)__builtin_amdgcn_s_getreg((3 << 11) | 20) & 0xFu; }
#define XB_SPIN(cond, bar) do { unsigned _sp = 0; while (cond) { __builtin_amdgcn_s_sleep(1); \
    if ((++_sp & 255u) == 0u) { if (xb_ld(&(bar)[XB_TMO])) break; if (_sp > XB_SPIN_CAP) { atomicAdd(&(bar)[XB_TMO], 1u); break; } } } } while (0)

struct XcdBarrier { unsigned* bar; unsigned x; volatile LAS unsigned* st; };

__device__ __forceinline__ XcdBarrier xcd_barrier_post(unsigned* bar, volatile LAS unsigned* st) {
    XcdBarrier b; b.bar = bar; b.x = xb_xcc_id(); b.st = st;
    if (threadIdx.x == 0) (void)xb_add(&bar[XB_XCNT(b.x)], 1u);
    return b;
}
__device__ __forceinline__ void xcd_barrier_complete(unsigned* bar, unsigned x, unsigned& nloc, unsigned& nx) {
    const unsigned G = gridDim.x * gridDim.y * gridDim.z;
    unsigned sum, cnt, mine, sp = 0u;
    for (;;) {
        sum = 0u; cnt = 0u; mine = 0u;
#pragma unroll
        for (unsigned j = 0; j < 16; ++j) { const unsigned c = xb_ld(&bar[XB_XCNT(j)]); sum += c; cnt += (c > 0u) ? 1u : 0u; mine = (j == x) ? c : mine; }
        if (sum == G) break;
        __builtin_amdgcn_s_sleep(1);
        if ((++sp & 255u) == 0u) { if (xb_ld(&bar[XB_TMO])) break; if (sp > XB_SPIN_CAP) { atomicAdd(&bar[XB_TMO], 1u); break; } }
    }
    nloc = mine > 0u ? mine : 1u; nx = cnt > 0u ? cnt : 1u;
}
__device__ __forceinline__ void xcd_barrier(const XcdBarrier& b) {
    asm volatile("s_waitcnt vmcnt(0)" ::: "memory");
    __syncthreads();
    if (threadIdx.x == 0) {
        unsigned* bar = b.bar;
        __builtin_amdgcn_s_waitcnt(0);
        unsigned nloc = b.st[0], nx = b.st[1];
        if (nloc == 0u) { xcd_barrier_complete(bar, b.x, nloc, nx); b.st[0] = nloc; b.st[1] = nx; }
        const unsigned old = xb_add(&bar[XB_XSUB(b.x)], 1u);
        const unsigned gen = old / nloc;
        if (old + 1u == (gen + 1u) * nloc) {
            __builtin_amdgcn_fence(__ATOMIC_RELEASE, "agent");
            asm volatile("s_waitcnt vmcnt(0)" ::: "memory");
            const unsigned og = xb_add(&bar[XB_TOP], 1u);
            const unsigned tg = og / nx;
            if (og + 1u == (tg + 1u) * nx) xb_add(&bar[XB_TOPGEN], 1u);
            else XB_SPIN(xb_ld(&bar[XB_TOPGEN]) == tg, bar);
            __builtin_amdgcn_fence(__ATOMIC_ACQUIRE, "agent");
            xb_add(&bar[XB_XGEN(b.x)], 1u);
            asm volatile("s_waitcnt vmcnt(0)" ::: "memory");
        } else {
            XB_SPIN(xb_ld(&bar[XB_XGEN(b.x)]) == gen, bar);
            __builtin_amdgcn_fence(__ATOMIC_ACQUIRE, "agent");
            asm volatile("s_waitcnt vmcnt(0)" ::: "memory");
        }
    }
    __syncthreads();
}

namespace pg8 {
constexpr int BM = 256, BK = 64, HALF = 128, HTB = HALF * BK * 2, STAGE_BYTES = 8 * HTB, NXCD = 8, WGM = 8;
DI int lds_byte(int r, int c) { const int st = (r >> 4) * 2 + (c >> 5), rr = r & 15, cc = c & 31, ob = rr * 64 + cc * 2; return st * 1024 + (ob ^ (((ob >> 9) & 1) << 5)); }
DI void stage_rc(int b, int& R, int& C) { const int st = b / 1024, sb = b % 1024, swz = sb ^ (((sb >> 9) & 1) << 5); R = (st >> 1) * 16 + swz / 64; C = (st & 1) * 32 + (swz % 64) / 2; }
DI int perm32(int rho) { const int n = rho >> 4, i = rho & 15; return 8 * (i >> 2) + 4 * n + (i & 3); }

struct Unit { int pm, pn; };
struct Gemm { const u16* A; const u16* Bt; int lda, ldb, K; };

struct StaticOrder {
    int nM, nN, nwg, G, c;
    DI void init(int M, int N, int G_, int c_) { nM = M / BM; nN = N / BM; nwg = nM * nN; G = G_; c = c_; }
    DI bool next(int i, Unit& u) const {
        const long L = (long)i * G + c; if (L >= nwg) return false;
        int wgid = (int)L; { const int q = nwg / NXCD, r = nwg % NXCD, xcd = wgid % NXCD, off = wgid / NXCD; wgid = (xcd < r ? xcd * (q + 1) : r * (q + 1) + (xcd - r) * q) + off; }
        const int nig = WGM * nN, gid = wgid / nig, fm = gid * WGM, gsz = (nM - fm) < WGM ? (nM - fm) : WGM;
        u.pm = fm + ((wgid % nig) % gsz); u.pn = (wgid % nig) / gsz; return true;
    }
};

template <class Epi, class Sched>
DI void gemm_phase(LAS unsigned char* lds, const Gemm g, const Sched& S, const Epi& E) {
    const int tid = threadIdx.x, wid = __builtin_amdgcn_readfirstlane(tid >> 6), lane = tid & 63, wr = wid >> 2, wc = wid & 3, fr = lane & 15, fq = lane >> 4;
    const int K = g.K, nt = K / BK;
    unsigned voffA[2], voffB[2];
#pragma unroll
    for (int i = 0; i < 2; ++i) { int R, C; stage_rc(tid * 16 + i * 8192, R, C); const int Rb = Epi::PERM ? ((R & ~31) + perm32(R & 31)) : R;
        voffA[i] = (unsigned)(R * g.lda + C) * 2u; voffB[i] = (unsigned)(Rb * g.ldb + C) * 2u; }
    const size_t kstep = (size_t)(BK * 2);
    const size_t hstepA = (size_t)HALF * g.lda * 2, hstepB = (size_t)HALF * g.ldb * 2;
    const size_t tstepA = 2 * hstepA, tstepB = 2 * hstepB;
    const unsigned ldsw = (unsigned)wid * 1024u;
    const int aoff = lds_byte(wr * 64 + fr, fq * 8), boff = lds_byte(wc * 32 + fr, fq * 8);
#define PG8_SA(b, h) (((b) * 2 + (h)) * HTB)
#define PG8_SB(b, h) ((4 + (b) * 2 + (h)) * HTB)
#define PG8_STAGE(bufoff, gbase, voff) do { _Pragma("unroll") for (int _i = 0; _i < 2; ++_i) \
        __builtin_amdgcn_global_load_lds((const unsigned*)((const char*)(gbase) + (voff)[_i]), (LAS unsigned*)(lds + (bufoff) + ldsw + _i * 8192), 16, 0, 0); } while (0)
#define PG8_LDA(dst, b, h) do { _Pragma("unroll") for (int m = 0; m < 4; ++m) _Pragma("unroll") for (int k = 0; k < 2; ++k) dst[m][k] = *(const LAS bf16x8*)(lds + PG8_SA(b, h) + aoff + m * 2048 + k * 1024); } while (0)
#define PG8_LDB(dst, b, h) do { _Pragma("unroll") for (int n = 0; n < 2; ++n) _Pragma("unroll") for (int k = 0; k < 2; ++k) dst[n][k] = *(const LAS bf16x8*)(lds + PG8_SB(b, h) + boff + n * 2048 + k * 1024); } while (0)
#define PG8_MMA(ai, bj, At, Bt) do { __builtin_amdgcn_s_setprio(1); _Pragma("unroll") for (int m = 0; m < 4; ++m) _Pragma("unroll") for (int n = 0; n < 2; ++n) _Pragma("unroll") for (int k = 0; k < 2; ++k) \
        acc[ai][bj][m][n] = __builtin_amdgcn_mfma_f32_16x16x32_bf16(Bt[n][k], At[m][k], acc[ai][bj][m][n], 0, 0, 0); __builtin_amdgcn_s_setprio(0); } while (0)
#define PG8_WAIT_V(n) asm volatile("s_waitcnt vmcnt(" #n ")" ::: "memory")
#define PG8_WAIT_L(n) asm volatile("s_waitcnt lgkmcnt(" #n ")" ::: "memory")
#define PG8_BAR __builtin_amdgcn_s_barrier()
#define PG8_SCHED __builtin_amdgcn_sched_barrier(0)
    Unit cur, nxt; int ui = 0;
    if (!S.next(0, cur)) return;
    f32x4 acc[2][2][4][2];
#pragma unroll
    for (int a = 0; a < 2; ++a)
#pragma unroll
        for (int b = 0; b < 2; ++b)
#pragma unroll
            for (int m = 0; m < 4; ++m)
#pragma unroll
                for (int n = 0; n < 2; ++n) acc[a][b][m][n] = (f32x4){0.f, 0.f, 0.f, 0.f};
    bf16x8 At[4][2], B0[2][2], B1[2][2];
    const char* cA = (const char*)g.A + (size_t)cur.pm * tstepA; const char* cB = (const char*)g.Bt + (size_t)cur.pn * tstepB;
    PG8_STAGE(PG8_SB(0, 0), cB, voffB); PG8_STAGE(PG8_SA(0, 0), cA, voffA); PG8_STAGE(PG8_SB(0, 1), cB + hstepB, voffB); PG8_STAGE(PG8_SA(0, 1), cA + hstepA, voffA);
    if (wr == 1) PG8_BAR;
    PG8_WAIT_V(4); PG8_BAR;
    PG8_STAGE(PG8_SB(1, 0), cB + kstep, voffB); PG8_STAGE(PG8_SA(1, 0), cA + kstep, voffA); PG8_STAGE(PG8_SB(1, 1), cB + hstepB + kstep, voffB);
    PG8_WAIT_V(6); PG8_BAR;
    for (;;) {
        const bool has_next = S.next(ui + 1, nxt);
        const char* nA = has_next ? (const char*)g.A + (size_t)nxt.pm * tstepA : cA; const char* nB = has_next ? (const char*)g.Bt + (size_t)nxt.pn * tstepB : cB;
        for (int t = 0; t < nt; t += 2) {
            const bool last = (t == nt - 2);
            const char* a1 = cA + (size_t)(t + 1) * kstep;
            const char* a2 = last ? nA : cA + (size_t)(t + 2) * kstep; const char* b2 = last ? nB : cB + (size_t)(t + 2) * kstep;
            const char* a3 = a2 + kstep; const char* b3 = b2 + kstep;
            PG8_LDB(B0, 0, 0); PG8_SCHED; PG8_LDA(At, 0, 0); PG8_STAGE(PG8_SA(1, 1), a1 + hstepA, voffA);
            PG8_WAIT_L(8); PG8_BAR; PG8_WAIT_L(0); PG8_MMA(0, 0, At, B0); PG8_BAR; PG8_SCHED;
            PG8_LDB(B1, 0, 1); PG8_STAGE(PG8_SB(0, 0), b2, voffB);
            PG8_BAR; PG8_WAIT_L(0); PG8_MMA(0, 1, At, B1); PG8_BAR;
            PG8_LDA(At, 0, 1); PG8_STAGE(PG8_SA(0, 0), a2, voffA);
            PG8_BAR; PG8_WAIT_L(0); PG8_MMA(1, 0, At, B0); PG8_BAR; PG8_SCHED;
            PG8_STAGE(PG8_SB(0, 1), b2 + hstepB, voffB);
            PG8_WAIT_V(6); PG8_BAR; PG8_MMA(1, 1, At, B1); PG8_BAR;
            PG8_LDB(B0, 1, 0); PG8_SCHED; PG8_LDA(At, 1, 0); PG8_STAGE(PG8_SA(0, 1), a2 + hstepA, voffA);
            PG8_WAIT_L(8); PG8_BAR; PG8_WAIT_L(0); PG8_MMA(0, 0, At, B0); PG8_BAR; PG8_SCHED;
            PG8_LDB(B1, 1, 1); PG8_STAGE(PG8_SB(1, 0), b3, voffB);
            PG8_BAR; PG8_WAIT_L(0); PG8_MMA(0, 1, At, B1); PG8_BAR;
            PG8_LDA(At, 1, 1); PG8_STAGE(PG8_SA(1, 0), a3, voffA);
            PG8_BAR; PG8_WAIT_L(0); PG8_MMA(1, 0, At, B0); PG8_BAR; PG8_SCHED;
            PG8_STAGE(PG8_SB(1, 1), b3 + hstepB, voffB);
            PG8_WAIT_V(6); PG8_BAR; PG8_MMA(1, 1, At, B1); PG8_BAR;
        }
        E(acc, cur, wr, wc, fr, fq);
        if (!has_next) break;
#pragma unroll
        for (int a = 0; a < 2; ++a)
#pragma unroll
            for (int b = 0; b < 2; ++b)
#pragma unroll
                for (int m = 0; m < 4; ++m)
#pragma unroll
                    for (int n = 0; n < 2; ++n) acc[a][b][m][n] = (f32x4){0.f, 0.f, 0.f, 0.f};
        cur = nxt; cA = nA; cB = nB; ++ui;
    }
    PG8_WAIT_V(0);
    if (wr == 0) PG8_BAR;
    PG8_BAR;
#undef PG8_SA
#undef PG8_SB
#undef PG8_STAGE
#undef PG8_LDA
#undef PG8_LDB
#undef PG8_MMA
#undef PG8_WAIT_V
#undef PG8_WAIT_L
#undef PG8_BAR
#undef PG8_SCHED
}

struct EpiBf16 {
    static constexpr bool PERM = true;
    u16* O; int ldc; int pnmask;
    DI void operator()(const f32x4 (&acc)[2][2][4][2], const Unit& u, int wr, int wc, int fr, int fq) const {
        const int row0 = u.pm * BM + wr * 64 + fr, col0 = (u.pn & pnmask) * BM + wc * 32 + 8 * fq;
#pragma unroll
        for (int ai = 0; ai < 2; ++ai)
#pragma unroll
            for (int m = 0; m < 4; ++m) { u16* rowp = O + (size_t)(row0 + ai * HALF + m * 16) * ldc + col0;
#pragma unroll
                for (int bj = 0; bj < 2; ++bj) { const f32x4 v0 = acc[ai][bj][m][0], v1 = acc[ai][bj][m][1];
                    u32x4 w; w.x = pack_bf2(v0[0], v0[1]); w.y = pack_bf2(v0[2], v0[3]); w.z = pack_bf2(v1[0], v1[1]); w.w = pack_bf2(v1[2], v1[3]);
                    *(u32x4*)(rowp + bj * HALF) = w; } }
    }
};
struct EpiF32Res {
    static constexpr bool PERM = false;
    float* C; const float* R; int ldc;
    DI void operator()(const f32x4 (&acc)[2][2][4][2], const Unit& u, int wr, int wc, int fr, int fq) const {
        const int row0 = u.pm * BM + wr * 64 + fr, col0 = u.pn * BM + wc * 32 + 4 * fq;
#pragma unroll
        for (int ai = 0; ai < 2; ++ai)
#pragma unroll
            for (int m = 0; m < 4; ++m) { const size_t ro = (size_t)(row0 + ai * HALF + m * 16) * ldc + col0;
#pragma unroll
                for (int bj = 0; bj < 2; ++bj)
#pragma unroll
                    for (int n = 0; n < 2; ++n) { const f32x4 r = *(const f32x4*)(R + ro + bj * HALF + n * 16); *(f32x4*)(C + ro + bj * HALF + n * 16) = acc[ai][bj][m][n] + r; } }
    }
};

struct EpiGU {
    static constexpr bool PERM = false;
    u16* H;
    DI void operator()(const f32x4 (&acc)[2][2][4][2], const Unit& u, int wr, int wc, int fr, int fq) const {
        const int row0 = u.pm * BM + wr * 64 + fr, pnl = u.pn & 3;
#pragma unroll
        for (int ai = 0; ai < 2; ++ai)
#pragma unroll
            for (int m = 0; m < 4; ++m) { u16* rowp = H + (size_t)(row0 + ai * HALF + m * 16) * 512;
#pragma unroll
                for (int bj = 0; bj < 2; ++bj) { const f32x4 gv = acc[ai][bj][m][0], uv = acc[ai][bj][m][1];
                    float hv[4];
#pragma unroll
                    for (int j = 0; j < 4; ++j) hv[j] = gv[j] / (1.f + __expf(-gv[j])) * uv[j];
                    u32x2 w; w.x = pack_bf2(hv[0], hv[1]); w.y = pack_bf2(hv[2], hv[3]);
                    *(u32x2*)(rowp + 16 * (8 * pnl + 4 * bj + wc) + 4 * fq) = w; } }
    }
};
struct MoeOrder {
    const LAS int* seg; int G, c;
    DI bool next(int i, Unit& u) const {
        const int L = i * G + c, ntr = seg[16] >> 8; if (L >= ntr * 4) return false;
        const int pm = L >> 2; int e = 0;
#pragma unroll
        for (int k = 1; k < 16; ++k) e += (pm * 256 >= seg[k]) ? 1 : 0;
        u.pm = pm; u.pn = e * 4 + (L & 3); return true;
    }
};
}

struct Params {
    const float* in[30];
    float* out;
    unsigned char* ws;
    int ph_lo, ph_hi;
    double invf[32];
};

DI void cvt_tile(LAS unsigned char* lds, const float* src, int ld_src, int n_valid, int k0, int n0, u16* dst, int ld_dst, int mode) {
    LAS float* tile = (LAS float*)lds;
    const int tid = threadIdx.x;
    f32x4 v[8];
#pragma unroll
    for (int i = 0; i < 8; ++i) {
        const int e = tid + i * 512, kk = e >> 6, n4 = (e & 63) * 4;
        v[i] = (f32x4){0.f, 0.f, 0.f, 0.f};
        if (n0 + n4 < n_valid) v[i] = *(const f32x4*)(src + (size_t)(k0 + kk) * ld_src + n0 + n4);
    }
#pragma unroll
    for (int i = 0; i < 8; ++i) {
        const int e = tid + i * 512, kk = e >> 6, n4 = (e & 63) * 4;
        tile[kk * 257 + n4 + 0] = v[i][0]; tile[kk * 257 + n4 + 1] = v[i][1]; tile[kk * 257 + n4 + 2] = v[i][2]; tile[kk * 257 + n4 + 3] = v[i][3];
    }
    __syncthreads();
#pragma unroll
    for (int o = 0; o < 4; ++o) {
        const int nn = (tid >> 3) + 64 * o, kc = (tid & 7) * 8;
        float f[8];
#pragma unroll
        for (int j = 0; j < 8; ++j) f[j] = tile[(kc + j) * 257 + nn];
        const int n = n0 + nn;
        const int drow = mode == 0 ? n : (32 * (n >> 4) + (n & 15) + (mode == 2 ? 16 : 0));
        u32x4 w; w.x = pack_bf2(f[0], f[1]); w.y = pack_bf2(f[2], f[3]); w.z = pack_bf2(f[4], f[5]); w.w = pack_bf2(f[6], f[7]);
        *(u32x4*)(dst + (size_t)drow * ld_dst + k0 + kc) = w;
    }
    __syncthreads();
}
DI int cvt_matrix(LAS unsigned char* lds, int base, const float* src, int K, int N, int n_valid, u16* dst, int ld_dst, int mode) {
    const int tn = N / 256, ntile = (K / 64) * tn, G = gridDim.x;
    const int first = ((int)blockIdx.x - base % G + G) % G;
    for (int t = first; t < ntile; t += G) cvt_tile(lds, src, n_valid, n_valid, (t / tn) * 64, (t % tn) * 256, dst, ld_dst, mode);
    return base + ntile;
}

DI void rmsnorm_rows(const float* src, const float* g, u16* dst) {
    const int lane = threadIdx.x & 63, wave = threadIdx.x >> 6;
    f32x4 gv[4];
#pragma unroll
    for (int i = 0; i < 4; ++i) gv[i] = *(const f32x4*)(g + lane * 4 + 256 * i);
    for (int row0 = (blockIdx.x * 8 + wave) * 4; row0 < T_; row0 += gridDim.x * 32) {
        f32x4 v[4][4]; float ss[4];
#pragma unroll
        for (int q = 0; q < 4; ++q)
#pragma unroll
            for (int i = 0; i < 4; ++i) v[q][i] = *(const f32x4*)(src + (size_t)(row0 + q) * D_ + lane * 4 + 256 * i);
#pragma unroll
        for (int q = 0; q < 4; ++q) { ss[q] = 0.f;
#pragma unroll
            for (int i = 0; i < 4; ++i) ss[q] += v[q][i][0] * v[q][i][0] + v[q][i][1] * v[q][i][1] + v[q][i][2] * v[q][i][2] + v[q][i][3] * v[q][i][3];
            ss[q] = wave_sum(ss[q]); }
#pragma unroll
        for (int q = 0; q < 4; ++q) { const float r = rsqrtf(ss[q] * (1.f / D_) + EPS);
#pragma unroll
            for (int i = 0; i < 4; ++i) { u32x2 w; w.x = pack_bf2(v[q][i][0] * r * gv[i][0], v[q][i][1] * r * gv[i][1]); w.y = pack_bf2(v[q][i][2] * r * gv[i][2], v[q][i][3] * r * gv[i][3]);
                *(u32x2*)(dst + (size_t)(row0 + q) * D_ + lane * 4 + 256 * i) = w; } }
    }
}

DI int vperm16(int p) { const int hh = p >> 3, j = p & 7; return 8 * (j >> 2) + 4 * hh + (j & 3); }
DI void post_l0(LAS unsigned char* lds, u16* proj, const float* qg, const float* kg, const float* zg, u16* vt, u16* zt) {
    const int tid = threadIdx.x, lane = tid & 63, wave = tid >> 6;
    LAS u16* vtile = (LAS u16*)lds;
    LAS u16* ztile = (LAS u16*)(lds + 65536);
    for (int unit = blockIdx.x; unit < T_ / 64; unit += gridDim.x) {
        const int tok0 = unit * 64;
        for (int tl = wave * 8; tl < wave * 8 + 8; ++tl) {
            u16* row = proj + (size_t)(tok0 + tl) * AB_COLS;
            const int d0 = (lane & 7) * 8;
#pragma unroll
            for (int i = 0; i < 2; ++i) {
                u32x4 w = *(const u32x4*)(row + i * 512 + lane * 8);
                float f[8] = {bf_lo(w.x), bf_hi(w.x), bf_lo(w.y), bf_hi(w.y), bf_lo(w.z), bf_hi(w.z), bf_lo(w.w), bf_hi(w.w)};
                float ss = 0.f;
#pragma unroll
                for (int j = 0; j < 8; ++j) ss += f[j] * f[j];
                ss += __shfl_xor(ss, 1); ss += __shfl_xor(ss, 2); ss += __shfl_xor(ss, 4);
                const float r = rsqrtf(ss * (1.f / 64.f) + EPS);
                const float* gp = (i == 0 ? qg : kg) + d0;
#pragma unroll
                for (int j = 0; j < 8; ++j) f[j] = f[j] * r * gp[j];
                w.x = pack_bf2(f[0], f[1]); w.y = pack_bf2(f[2], f[3]); w.z = pack_bf2(f[4], f[5]); w.w = pack_bf2(f[6], f[7]);
                *(u32x4*)(row + i * 512 + lane * 8) = w;
            }
            { const u32x4 w = *(const u32x4*)(row + 1024 + lane * 8); *(LAS u32x4*)(vtile + tl * 512 + lane * 8) = w; }
            { u32x4 w = *(const u32x4*)(row + 1536 + lane * 8);
              float f[8] = {bf_lo(w.x), bf_hi(w.x), bf_lo(w.y), bf_hi(w.y), bf_lo(w.z), bf_hi(w.z), bf_lo(w.w), bf_hi(w.w)};
#pragma unroll
              for (int j = 0; j < 8; ++j) f[j] = gelu_tanh(f[j]);
              w.x = pack_bf2(f[0], f[1]); w.y = pack_bf2(f[2], f[3]); w.z = pack_bf2(f[4], f[5]); w.w = pack_bf2(f[6], f[7]);
              *(u32x4*)(row + 1536 + lane * 8) = w; }
            { u32x4 w = *(const u32x4*)(row + 2048 + lane * 8);
              float f[8] = {bf_lo(w.x), bf_hi(w.x), bf_lo(w.y), bf_hi(w.y), bf_lo(w.z), bf_hi(w.z), bf_lo(w.w), bf_hi(w.w)};
              float ss = 0.f;
#pragma unroll
              for (int j = 0; j < 8; ++j) { f[j] = gelu_tanh(f[j]); ss += f[j] * f[j]; }
              ss += __shfl_xor(ss, 1); ss += __shfl_xor(ss, 2); ss += __shfl_xor(ss, 4);
              const float r = rsqrtf(ss * (1.f / 64.f) + EPS);
              const float* gp = zg + lane * 8;
#pragma unroll
              for (int j = 0; j < 8; ++j) f[j] = f[j] * r * gp[j];
              w.x = pack_bf2(f[0], f[1]); w.y = pack_bf2(f[2], f[3]); w.z = pack_bf2(f[4], f[5]); w.w = pack_bf2(f[6], f[7]);
              *(LAS u32x4*)(ztile + tl * 512 + lane * 8) = w; }
        }
        __syncthreads();
        {
            const int col = tid, b = tok0 / S_, s0 = tok0 % S_;
            u16* vdst = vt + ((size_t)(b * 512 + col)) * S_ + s0;
            u16* zdst = zt + ((size_t)(b * 512 + col)) * S_ + s0;
#pragma unroll
            for (int c = 0; c < 8; ++c) {
                unsigned vw[4], zw[4];
#pragma unroll
                for (int j = 0; j < 4; ++j) {
                    const int p0 = c * 8 + 2 * j, p1 = p0 + 1;
                    const int k0 = (p0 & ~15) + vperm16(p0 & 15), k1 = (p1 & ~15) + vperm16(p1 & 15);
                    vw[j] = (unsigned)vtile[k0 * 512 + col] | ((unsigned)vtile[k1 * 512 + col] << 16);
                    zw[j] = (unsigned)ztile[p0 * 512 + col] | ((unsigned)ztile[p1 * 512 + col] << 16);
                }
                *(u32x4*)(vdst + c * 8) = (u32x4){vw[0], vw[1], vw[2], vw[3]};
                *(u32x4*)(zdst + c * 8) = (u32x4){zw[0], zw[1], zw[2], zw[3]};
            }
        }
        __syncthreads();
    }
}

constexpr int KP = 72;
DI void sb_attn_unit(LAS unsigned char* lds, const u16* proj, const u16* vt, u16* mixed, int b, int h, int qb) {
    const int tid = threadIdx.x, lane = tid & 63, wave = __builtin_amdgcn_readfirstlane(tid >> 6), r = lane & 31, hh = lane >> 5;
    LAS u16* Ks = (LAS u16*)lds;
    LAS u16* Vs = (LAS u16*)(lds + 64 * KP * 2);
    const int q0 = qb * 256, qrow = q0 + wave * 32 + r;
    const size_t tokq = (size_t)b * S_ + qrow;
    bf16x8 qf[4];
#pragma unroll
    for (int kk = 0; kk < 4; ++kk) qf[kk] = *(const bf16x8*)(proj + tokq * AB_COLS + h * 64 + kk * 16 + hh * 8);
    f32x16 o0, o1;
#pragma unroll
    for (int i = 0; i < 16; ++i) { o0[i] = 0.f; o1[i] = 0.f; }
    float carry = 0.f;
    const int wave_qmax = q0 + wave * 32 + 31;
    const int srow = tid >> 3, sc8 = (tid & 7) * 8;
    const u16* kgp = proj + ((size_t)b * S_ + srow) * AB_COLS + 512 + h * 64 + sc8;
    const u16* vgp = vt + ((size_t)(b * 8 + h) * 64 + srow) * S_ + sc8;
    int kt = qb * 4 + 3;
    u32x4 kreg = *(const u32x4*)(kgp + (size_t)kt * 64 * AB_COLS), vreg = *(const u32x4*)(vgp + kt * 64);
    bool wdone = false;
    for (;;) {
        if (!__syncthreads_or(wdone ? 0 : 1)) break;
        *(LAS u32x4*)(Ks + srow * KP + sc8) = kreg;
        *(LAS u32x4*)(Vs + srow * KP + sc8) = vreg;
        __syncthreads();
        if (kt > 0) { kreg = *(const u32x4*)(kgp + (size_t)(kt - 1) * 64 * AB_COLS); vreg = *(const u32x4*)(vgp + (kt - 1) * 64); }
        if (!wdone && kt * 64 < wave_qmax) {
#pragma unroll
        for (int sub = 1; sub >= 0; --sub) {
            f32x16 s;
#pragma unroll
            for (int i = 0; i < 16; ++i) s[i] = 0.f;
#pragma unroll
            for (int kk = 0; kk < 4; ++kk) {
                const bf16x8 kf = *(const LAS bf16x8*)(Ks + (sub * 32 + r) * KP + kk * 16 + hh * 8);
                s = __builtin_amdgcn_mfma_f32_32x32x16_bf16(kf, qf[kk], s, 0, 0, 0);
            }
            const int kbase = kt * 64 + sub * 32 + 4 * hh;
            float a[16], z[16];
#pragma unroll
            for (int i = 0; i < 16; ++i) {
                const int key = kbase + (i & 3) + 8 * (i >> 2);
                z[i] = s[i] * 0.125f;
                const float sp = fmaxf(z[i], 0.f) + __logf(1.f + __expf(-fabsf(z[i])));
                a[i] = key < qrow ? sp : 0.f;
            }
            float bs[4], pbs[4];
#pragma unroll
            for (int g = 0; g < 4; ++g) { bs[g] = (a[4 * g] + a[4 * g + 1]) + (a[4 * g + 2] + a[4 * g + 3]); pbs[g] = xor32(bs[g], hh); }
            float suf = 0.f;
            f32x16 p;
#pragma unroll
            for (int g = 3; g >= 0; --g) {
                const float E = carry + suf + (hh == 0 ? pbs[g] : 0.f);
                float run = E;
#pragma unroll
                for (int e = 3; e >= 0; --e) {
                    const int i = 4 * g + e, key = kbase + e + 8 * g;
                    const float w = __expf(z[i] - a[i] - run);
                    p[i] = key < qrow ? w : 0.f;
                    run += a[i];
                }
                suf += bs[g] + pbs[g];
            }
            carry += suf;
#pragma unroll
            for (int s2 = 0; s2 < 2; ++s2) {
                u32x4 pw; pw.x = pack_bf2(p[8 * s2 + 0], p[8 * s2 + 1]); pw.y = pack_bf2(p[8 * s2 + 2], p[8 * s2 + 3]); pw.z = pack_bf2(p[8 * s2 + 4], p[8 * s2 + 5]); pw.w = pack_bf2(p[8 * s2 + 6], p[8 * s2 + 7]);
                const bf16x8 pf = __builtin_bit_cast(bf16x8, pw);
                const int kcol = (sub * 2 + s2) * 16 + hh * 8;
                const bf16x8 v0 = *(const LAS bf16x8*)(Vs + r * KP + kcol);
                const bf16x8 v1 = *(const LAS bf16x8*)(Vs + (32 + r) * KP + kcol);
                o0 = __builtin_amdgcn_mfma_f32_32x32x16_bf16(v0, pf, o0, 0, 0, 0);
                o1 = __builtin_amdgcn_mfma_f32_32x32x16_bf16(v1, pf, o1, 0, 0, 0);
            }
        }
        wdone = __all(carry > 110.f);
        }
        if (--kt < 0) break;
    }
    __syncthreads();
    u16* orow = mixed + tokq * D_ + h * 64;
#pragma unroll
    for (int g = 0; g < 4; ++g) {
        u32x2 w0, w1;
        w0.x = pack_bf2(o0[4 * g], o0[4 * g + 1]); w0.y = pack_bf2(o0[4 * g + 2], o0[4 * g + 3]);
        w1.x = pack_bf2(o1[4 * g], o1[4 * g + 1]); w1.y = pack_bf2(o1[4 * g + 2], o1[4 * g + 3]);
        *(u32x2*)(orow + 8 * g + 4 * hh) = w0;
        *(u32x2*)(orow + 32 + 8 * g + 4 * hh) = w1;
    }
}

DI void sgu_unit(const u16* zt, const u16* wm, const float* bs, const u16* proj, u16* mixed, int b, int n, int g) {
    const int tid = threadIdx.x, lane = tid & 63, wave = tid >> 6, r = lane & 31, hh = lane >> 5;
    const int dt = wave & 1, it = wave >> 1;
    const u16* zrow = zt + ((size_t)(b * 8 + g) * 64 + dt * 32 + r) * S_ + n * 128;
    const u16* wrow = wm + ((size_t)g * 128 + it * 32 + r) * 128;
    f32x16 c;
#pragma unroll
    for (int i = 0; i < 16; ++i) c[i] = 0.f;
#pragma unroll
    for (int kk = 0; kk < 8; ++kk) {
        const bf16x8 af = *(const bf16x8*)(zrow + kk * 16 + hh * 8);
        const bf16x8 bf = *(const bf16x8*)(wrow + kk * 16 + hh * 8);
        c = __builtin_amdgcn_mfma_f32_32x32x16_bf16(af, bf, c, 0, 0, 0);
    }
    const int i_loc = it * 32 + r;
    const size_t tok = (size_t)b * S_ + n * 128 + i_loc;
    const float bias = bs[g * 128 + i_loc];
#pragma unroll
    for (int q = 0; q < 4; ++q) {
        const int d = dt * 32 + 8 * q + 4 * hh;
        const u32x2 uw = *(const u32x2*)(proj + tok * AB_COLS + 1536 + g * 64 + d);
        u32x2 w;
        w.x = pack_bf2(bf_lo(uw.x) * (c[4 * q] + bias), bf_hi(uw.x) * (c[4 * q + 1] + bias));
        w.y = pack_bf2(bf_lo(uw.y) * (c[4 * q + 2] + bias), bf_hi(uw.y) * (c[4 * q + 3] + bias));
        *(u32x2*)(mixed + tok * D_ + 512 + g * 64 + d) = w;
    }
}


DI void router_phase(LAS unsigned char* lds, const float* h, const float* gain, const float* wg, const float* bg, const float* we, const float* be,
                     u16* xn, int* tok_e, float* tok_c, int* cnt) {
    const int tid = threadIdx.x, lane = tid & 63, wave = tid >> 6;
    LAS int* lcnt = (LAS int*)(lds + LDS_TAB);
    f32x4 gv[4];
#pragma unroll
    for (int i = 0; i < 4; ++i) gv[i] = *(const f32x4*)(gain + lane * 4 + 256 * i);
    for (int unit = blockIdx.x; unit < T_ / 64; unit += gridDim.x) {
        if (tid < 16) lcnt[tid] = 0;
        __syncthreads();
        for (int tl = 0; tl < 8; ++tl) {
            const int row = unit * 64 + wave * 8 + tl;
            const float* p = h + (size_t)row * D_;
            f32x4 v[4]; float ss = 0.f;
#pragma unroll
            for (int i = 0; i < 4; ++i) { v[i] = *(const f32x4*)(p + lane * 4 + 256 * i); ss += v[i][0] * v[i][0] + v[i][1] * v[i][1] + v[i][2] * v[i][2] + v[i][3] * v[i][3]; }
            ss = wave_sum(ss);
            const float r = rsqrtf(ss * (1.f / D_) + EPS);
            float gl[4] = {0.f, 0.f, 0.f, 0.f};
#pragma unroll
            for (int i = 0; i < 4; ++i) {
#pragma unroll
                for (int j = 0; j < 4; ++j) v[i][j] = v[i][j] * r * gv[i][j];
                u32x2 w; w.x = pack_bf2(v[i][0], v[i][1]); w.y = pack_bf2(v[i][2], v[i][3]);
                *(u32x2*)(xn + (size_t)row * D_ + lane * 4 + 256 * i) = w;
#pragma unroll
                for (int j = 0; j < 4; ++j) { const f32x4 wv = *(const f32x4*)(wg + (size_t)(lane * 4 + 256 * i + j) * 4);
                    gl[0] += v[i][j] * wv[0]; gl[1] += v[i][j] * wv[1]; gl[2] += v[i][j] * wv[2]; gl[3] += v[i][j] * wv[3]; }
            }
#pragma unroll
            for (int k = 0; k < 4; ++k) gl[k] = wave_sum(gl[k]) + bg[k];
            int gs = 0; float gm = gl[0];
#pragma unroll
            for (int k = 1; k < 4; ++k) if (gl[k] > gm) { gm = gl[k]; gs = k; }
            float gden = 0.f;
#pragma unroll
            for (int k = 0; k < 4; ++k) gden += __expf(gl[k] - gm);
            const float pgroup = 1.f / gden;
            gs = __builtin_amdgcn_readfirstlane(gs);
            const float* wep = we + (size_t)gs * 1024 * 4;
            float el[4] = {0.f, 0.f, 0.f, 0.f};
#pragma unroll
            for (int i = 0; i < 4; ++i)
#pragma unroll
                for (int j = 0; j < 4; ++j) { const f32x4 wv = *(const f32x4*)(wep + (size_t)(lane * 4 + 256 * i + j) * 4);
                    el[0] += v[i][j] * wv[0]; el[1] += v[i][j] * wv[1]; el[2] += v[i][j] * wv[2]; el[3] += v[i][j] * wv[3]; }
#pragma unroll
            for (int k = 0; k < 4; ++k) el[k] = wave_sum(el[k]) + be[gs * 4 + k];
            int i1 = 0; float m1 = el[0];
#pragma unroll
            for (int k = 1; k < 4; ++k) if (el[k] > m1) { m1 = el[k]; i1 = k; }
            int i2 = -1; float m2 = -3.0e38f;
#pragma unroll
            for (int k = 0; k < 4; ++k) if (k != i1 && el[k] > m2) { m2 = el[k]; i2 = k; }
            const float e2 = __expf(m2 - m1), inv = 1.f / (1.f + e2);
            if (lane == 0) {
                const int ea = gs * 4 + i1, eb = gs * 4 + i2;
                tok_e[row] = ea | (eb << 8);
                tok_c[row * 2] = pgroup * inv; tok_c[row * 2 + 1] = pgroup * e2 * inv;
                atomicAdd((int*)&lcnt[ea], 1); atomicAdd((int*)&lcnt[eb], 1);
            }
        }
        __syncthreads();
        if (tid < 16) cnt[unit * 16 + tid] = lcnt[tid];
        __syncthreads();
    }
}

DI void scatter_phase(LAS unsigned char* lds, const u16* xn, const int* tok_e, const int* cnt, int* tok_pos, int* seg_g, u16* xs) {
    const int tid = threadIdx.x, lane = tid & 63, wave = tid >> 6;
    LAS int* tot = (LAS int*)(lds + LDS_TAB);
    LAS int* mine = tot + 16;
    LAS int* seg = tot + 32;
    LAS int* lpos = tot + 64;
    for (int unit = blockIdx.x; unit < T_ / 64; unit += gridDim.x) {
        if (tid < 16) { int t = 0, m = 0; for (int u = 0; u < T_ / 64; ++u) { const int c = cnt[u * 16 + tid]; if (u == unit) m = t; t += c; } tot[tid] = t; mine[tid] = m; }
        __syncthreads();
        if (tid == 0) { int s = 0; for (int e = 0; e < 16; ++e) { seg[e] = s; s += (tot[e] + 255) & ~255; } seg[16] = s;
            if (unit == 0) for (int e = 0; e <= 16; ++e) seg_g[e] = seg[e]; }
        __syncthreads();
        if (wave == 0) {
            const int ee = tok_e[unit * 64 + lane], e0 = ee & 255, e1 = ee >> 8;
            const unsigned long long lt = (1ull << lane) - 1ull;
            int p0 = 0, p1 = 0;
#pragma unroll
            for (int ex = 0; ex < 16; ++ex) {
                const unsigned long long m0 = __ballot(e0 == ex), m1 = __ballot(e1 == ex);
                const int base = seg[ex] + mine[ex];
                if (e0 == ex) p0 = base + __popcll(m0 & lt);
                if (e1 == ex) p1 = base + __popcll(m0) + __popcll(m1 & lt);
            }
            tok_pos[(unit * 64 + lane) * 2] = p0; tok_pos[(unit * 64 + lane) * 2 + 1] = p1;
            lpos[lane * 2] = p0; lpos[lane * 2 + 1] = p1;
        }
        __syncthreads();
        for (int tl = wave * 8; tl < wave * 8 + 8; ++tl) {
            const u16* srow = xn + (size_t)(unit * 64 + tl) * D_;
            const u32x4 a = *(const u32x4*)(srow + lane * 8), b = *(const u32x4*)(srow + 512 + lane * 8);
#pragma unroll
            for (int k = 0; k < 2; ++k) { u16* drow = xs + (size_t)lpos[tl * 2 + k] * D_; *(u32x4*)(drow + lane * 8) = a; *(u32x4*)(drow + 512 + lane * 8) = b; }
        }
        __syncthreads();
    }
}

DI void combine_phase(float* h, const u16* yb, const int* tok_pos, const float* tok_c, const float* gain, u16* xn) {
    const int lane = threadIdx.x & 63, wave = threadIdx.x >> 6;
    for (int row = blockIdx.x * 8 + wave; row < T_; row += gridDim.x * 8) {
        float* p = h + (size_t)row * D_;
        const int p0 = tok_pos[row * 2], p1 = tok_pos[row * 2 + 1];
        const float c0 = tok_c[row * 2], c1 = tok_c[row * 2 + 1];
        f32x4 v[4]; float ss = 0.f;
#pragma unroll
        for (int i = 0; i < 4; ++i) {
            v[i] = *(const f32x4*)(p + lane * 4 + 256 * i);
            const u32x2 a = *(const u32x2*)(yb + (size_t)p0 * D_ + lane * 4 + 256 * i), b = *(const u32x2*)(yb + (size_t)p1 * D_ + lane * 4 + 256 * i);
            v[i][0] += c0 * bf_lo(a.x) + c1 * bf_lo(b.x); v[i][1] += c0 * bf_hi(a.x) + c1 * bf_hi(b.x);
            v[i][2] += c0 * bf_lo(a.y) + c1 * bf_lo(b.y); v[i][3] += c0 * bf_hi(a.y) + c1 * bf_hi(b.y);
            *(f32x4*)(p + lane * 4 + 256 * i) = v[i];
            ss += v[i][0] * v[i][0] + v[i][1] * v[i][1] + v[i][2] * v[i][2] + v[i][3] * v[i][3];
        }
        if (gain) {
            ss = wave_sum(ss);
            const float r = rsqrtf(ss * (1.f / D_) + EPS);
#pragma unroll
            for (int i = 0; i < 4; ++i) { const f32x4 gvv = *(const f32x4*)(gain + lane * 4 + 256 * i);
                u32x2 w; w.x = pack_bf2(v[i][0] * r * gvv[0], v[i][1] * r * gvv[1]); w.y = pack_bf2(v[i][2] * r * gvv[2], v[i][3] * r * gvv[3]);
                *(u32x2*)(xn + (size_t)row * D_ + lane * 4 + 256 * i) = w; }
        }
    }
}

DI void sincos_rev(int pos, double invf, float& c, float& s) {
    const double rev = (double)pos * invf * 0.15915494309189535;
    const float fr = (float)(rev - __builtin_rint(rev));
    s = __builtin_amdgcn_sinf(fr); c = __builtin_amdgcn_cosf(fr);
}
DI void unpack8(const u32x4 w, float (&f)[8]) { f[0] = bf_lo(w.x); f[1] = bf_hi(w.x); f[2] = bf_lo(w.y); f[3] = bf_hi(w.y); f[4] = bf_lo(w.z); f[5] = bf_hi(w.z); f[6] = bf_lo(w.w); f[7] = bf_hi(w.w); }
DI u32x4 pack8(const float (&f)[8]) { u32x4 w; w.x = pack_bf2(f[0], f[1]); w.y = pack_bf2(f[2], f[3]); w.z = pack_bf2(f[4], f[5]); w.w = pack_bf2(f[6], f[7]); return w; }
DI void transpose_write_v(const LAS u16* vtile, u16* dst, int tok0) {
    const int col = threadIdx.x, b = tok0 / S_, s0 = tok0 % S_;
    u16* vdst = dst + ((size_t)(b * 512 + col)) * S_ + s0;
#pragma unroll
    for (int c = 0; c < 8; ++c) {
        unsigned vw[4];
#pragma unroll
        for (int j = 0; j < 4; ++j) {
            const int p0 = c * 8 + 2 * j, p1 = p0 + 1;
            const int k0 = (p0 & ~15) + vperm16(p0 & 15), k1 = (p1 & ~15) + vperm16(p1 & 15);
            vw[j] = (unsigned)vtile[k0 * 512 + col] | ((unsigned)vtile[k1 * 512 + col] << 16);
        }
        *(u32x4*)(vdst + c * 8) = (u32x4){vw[0], vw[1], vw[2], vw[3]};
    }
}

DI void post_l1a(LAS unsigned char* lds, u16* proj1, const int* positions, const double* invf, const float* qlat_g, const float* kvlat_g, const float* kr_g, const float* dq_g, const float* dk_g,
                 u16* lat, u16* krope, u16* ikp, float* iwp, u16* vdt) {
    const int tid = threadIdx.x, lane = tid & 63, wave = tid >> 6;
    LAS u16* vtile = (LAS u16*)lds;
    for (int unit = blockIdx.x; unit < T_ / 64; unit += gridDim.x) {
        const int tok0 = unit * 64;
        for (int tl = wave * 8; tl < wave * 8 + 8; ++tl) {
            const int tok = tok0 + tl, pos = positions[tok];
            u16* row = proj1 + (size_t)tok * CD_PAD;
            {
                const int colA = lane < 32 ? lane * 8 : lane < 48 ? 256 + (lane - 32) * 8 : lane < 52 ? 384 + (lane - 48) * 8 : lane < 56 ? 2208 + (lane - 52) * 8 : lane == 56 ? 2240 : 0;
                float f[8]; unpack8(*(const u32x4*)(row + colA), f);
                float ss = 0.f;
#pragma unroll
                for (int j = 0; j < 8; ++j) ss += f[j] * f[j];
                ss += __shfl_xor(ss, 1); ss += __shfl_xor(ss, 2); const float ss4 = ss;
                ss += __shfl_xor(ss, 4); ss += __shfl_xor(ss, 8); const float ss16 = ss;
                ss += __shfl_xor(ss, 16); const float ss32 = ss;
                const int ksub = (lane - 48) & 3;
                float xk[8], pk[8];
                { const float r = rsqrtf(ss4 * (1.f / 32.f) + EPS);
#pragma unroll
                  for (int j = 0; j < 8; ++j) xk[j] = f[j] * r * kr_g[ksub * 8 + j]; }
#pragma unroll
                for (int j = 0; j < 8; ++j) pk[j] = __shfl_xor(xk[j], 2);
                if (lane < 32) {
                    const float r = rsqrtf(ss32 * (1.f / 256.f) + EPS); float o[8];
#pragma unroll
                    for (int j = 0; j < 8; ++j) o[j] = f[j] * r * qlat_g[lane * 8 + j];
                    *(u32x4*)(lat + (size_t)tok * 512 + lane * 8) = pack8(o);
                } else if (lane < 48) {
                    const float r = rsqrtf(ss16 * (1.f / 128.f) + EPS); float o[8];
#pragma unroll
                    for (int j = 0; j < 8; ++j) o[j] = f[j] * r * kvlat_g[(lane - 32) * 8 + j];
                    *(u32x4*)(lat + (size_t)tok * 512 + 256 + (lane - 32) * 8) = pack8(o);
                } else if (lane < 52) {
                    float o[8];
#pragma unroll
                    for (int j = 0; j < 8; ++j) { float c, s; sincos_rev(pos, invf[(ksub & 1) * 8 + j], c, s); o[j] = ksub < 2 ? xk[j] * c - pk[j] * s : xk[j] * c + pk[j] * s; }
                    *(u32x4*)(krope + (size_t)tok * 32 + ksub * 8) = pack8(o);
                } else if (lane < 56) {
                    float o[8];
#pragma unroll
                    for (int j = 0; j < 8; ++j) o[j] = f[j];
                    if (lane == 52) {
#pragma unroll
                        for (int j = 0; j < 4; ++j) { float c, s; sincos_rev(pos, invf[24 + j], c, s); o[j] = f[j] * c - f[j + 4] * s; o[j + 4] = f[j + 4] * c + f[j] * s; } }
                    *(u32x4*)(ikp + (size_t)tok * 32 + (lane - 52) * 8) = pack8(o);
                } else if (lane == 56) {
#pragma unroll
                    for (int j = 0; j < 8; ++j) iwp[(size_t)tok * 8 + j] = f[j] * 0.0625f;
                }
                if (lane >= 48) *(u32x4*)(lat + (size_t)tok * 512 + 384 + (lane - 48) * 8) = (u32x4){0u, 0u, 0u, 0u};
            }
            {
                const int sub = lane & 7;
                float c16[8], s16[8];
#pragma unroll
                for (int j = 0; j < 8; ++j) sincos_rev(pos, invf[16 + j], c16[j], s16[j]);
#pragma unroll
                for (int i = 0; i < 2; ++i) {
                    u16* p = row + 416 + i * 512 + lane * 8;
                    float f[8]; unpack8(*(const u32x4*)p, f);
                    float ss = 0.f;
#pragma unroll
                    for (int j = 0; j < 8; ++j) ss += f[j] * f[j];
                    ss += __shfl_xor(ss, 1); ss += __shfl_xor(ss, 2); ss += __shfl_xor(ss, 4);
                    const float r = rsqrtf(ss * (1.f / 64.f) + EPS);
                    const float* gp = (i == 0 ? dq_g : dk_g) + sub * 8;
                    float x[8], px[8], o[8];
#pragma unroll
                    for (int j = 0; j < 8; ++j) x[j] = f[j] * r * gp[j];
#pragma unroll
                    for (int j = 0; j < 8; ++j) px[j] = __shfl_xor(x[j], 1);
#pragma unroll
                    for (int j = 0; j < 8; ++j) o[j] = sub == 0 ? x[j] * c16[j] - px[j] * s16[j] : sub == 1 ? x[j] * c16[j] + px[j] * s16[j] : x[j];
                    *(u32x4*)p = pack8(o);
                }
            }
            { const u32x4 w = *(const u32x4*)(row + 1440 + lane * 8); *(LAS u32x4*)(vtile + tl * 512 + lane * 8) = w; }
            if (lane < 32 && (lane & 3) == 0) {
                u16* p = row + 1952 + lane * 8;
                float f[8], o[8]; unpack8(*(const u32x4*)p, f);
#pragma unroll
                for (int j = 0; j < 4; ++j) { float c, s; sincos_rev(pos, invf[24 + j], c, s); o[j] = f[j] * c - f[j + 4] * s; o[j + 4] = f[j + 4] * c + f[j] * s; }
                *(u32x4*)p = pack8(o);
            }
        }
        __syncthreads();
        transpose_write_v(vtile, vdt, tok0);
        __syncthreads();
    }
}

DI void post_l1b(LAS unsigned char* lds, u16* kvr, const float* kn_g, u16* vct) {
    const int tid = threadIdx.x, lane = tid & 63, wave = tid >> 6;
    LAS u16* vtile = (LAS u16*)lds;
    for (int unit = blockIdx.x; unit < T_ / 64; unit += gridDim.x) {
        const int tok0 = unit * 64;
        for (int tl = wave * 8; tl < wave * 8 + 8; ++tl) {
            u16* row = kvr + (size_t)(tok0 + tl) * 1024;
#pragma unroll
            for (int i = 0; i < 2; ++i) {
                const int chunk = lane + 64 * i, head = chunk >> 4, sub = chunk & 15;
                const u32x4 w = *(const u32x4*)(row + chunk * 8);
                float f[8]; unpack8(w, f);
                float ss = 0.f;
#pragma unroll
                for (int j = 0; j < 8; ++j) ss += f[j] * f[j];
                ss += __shfl_xor(ss, 1); ss += __shfl_xor(ss, 2); ss += __shfl_xor(ss, 4);
                if (sub < 8) {
                    const float r = rsqrtf(ss * (1.f / 64.f) + EPS); float o[8];
#pragma unroll
                    for (int j = 0; j < 8; ++j) o[j] = f[j] * r * kn_g[sub * 8 + j];
                    *(u32x4*)(row + chunk * 8) = pack8(o);
                } else {
                    *(LAS u32x4*)(vtile + tl * 512 + head * 64 + (sub - 8) * 8) = w;
                }
            }
        }
        __syncthreads();
        transpose_write_v(vtile, vct, tok0);
        __syncthreads();
    }
}

DI unsigned fkey(float f) { const unsigned u = __float_as_uint(f); return (u & 0x80000000u) ? ~u : (u | 0x80000000u); }
DI void idx_scores(const u16* ikp, size_t tokk, int hh, const bf16x8 a0, const bf16x8 a1, const float (&wa)[8], const float (&wb)[8], float& sa, float& sb) {
    const bf16x8 b0 = *(const bf16x8*)(ikp + tokk * 32 + hh * 8), b1 = *(const bf16x8*)(ikp + tokk * 32 + 16 + hh * 8);
    f32x16 c;
#pragma unroll
    for (int i = 0; i < 16; ++i) c[i] = 0.f;
    c = __builtin_amdgcn_mfma_f32_32x32x16_bf16(a0, b0, c, 0, 0, 0);
    c = __builtin_amdgcn_mfma_f32_32x32x16_bf16(a1, b1, c, 0, 0, 0);
    sa = 0.f; sb = 0.f;
#pragma unroll
    for (int h = 0; h < 8; ++h) { sa = __builtin_fmaf(wa[h], fmaxf(c[h], 0.f), sa); sb = __builtin_fmaf(wb[h], fmaxf(c[8 + h], 0.f), sb); }
}
DI void idx_load4(const u16* ikp, size_t tokb, int t0, int NT, int r, int hh, bf16x8 (&b)[4][2]) {
#pragma unroll
    for (int u = 0; u < 4; ++u) { const int t = (t0 + u < NT) ? t0 + u : NT - 1; const u16* p = ikp + (tokb + t * 32 + r) * 32 + hh * 8; b[u][0] = *(const bf16x8*)p; b[u][1] = *(const bf16x8*)(p + 16); }
}
DI void idx_score2(const bf16x8 a0, const bf16x8 a1, const bf16x8 b0, const bf16x8 b1, const float (&wa)[8], const float (&wb)[8], float& sa, float& sb) {
    f32x16 c;
#pragma unroll
    for (int i = 0; i < 16; ++i) c[i] = 0.f;
    c = __builtin_amdgcn_mfma_f32_32x32x16_bf16(a0, b0, c, 0, 0, 0);
    c = __builtin_amdgcn_mfma_f32_32x32x16_bf16(a1, b1, c, 0, 0, 0);
    sa = 0.f; sb = 0.f;
#pragma unroll
    for (int h = 0; h < 8; ++h) { sa = __builtin_fmaf(wa[h], fmaxf(c[h], 0.f), sa); sb = __builtin_fmaf(wb[h], fmaxf(c[8 + h], 0.f), sb); }
}
DI void indexer_unit(LAS unsigned char* lds, const u16* proj1, const u16* ikp, const float* iwp, unsigned* mask, int b, int j32) {
    const int tid = threadIdx.x, lane = tid & 63, wave = __builtin_amdgcn_readfirstlane(tid >> 6), r = lane & 31, hh = lane >> 5;
    LAS unsigned* hist = (LAS unsigned*)lds + wave * 4096;
    const int s0 = j32 * 32 + wave * 4;
    const int NT = 2 * ((j32 >> 1) + 1);
    const size_t tokb = (size_t)b * S_;
    if (NT <= 8) {
        if (lane < 4) for (int t = 0; t < NT; ++t) mask[(tokb + s0 + lane) * 128 + t] = 0xffffffffu;
        return;
    }
    bf16x8 a0, a1;
    { const int g = r >> 3, hr = (r >> 2) & 1, i = r & 3, qA = 2 * hr + (g >> 1), head = 4 * (g & 1) + i;
      const u16* p = proj1 + (tokb + s0 + qA) * CD_PAD + 1952 + head * 32 + hh * 8;
      a0 = *(const bf16x8*)p; a1 = *(const bf16x8*)(p + 16); }
    float wa[8], wb[8];
#pragma unroll
    for (int h = 0; h < 8; ++h) { wa[h] = iwp[(tokb + s0 + 2 * hh) * 8 + h]; wb[h] = iwp[(tokb + s0 + 2 * hh + 1) * 8 + h]; }
    unsigned pre0 = 0u, pre1 = 0u, pre2 = 0u, pre3 = 0u; int kr0 = 256, kr1 = 256, kr2 = 256, kr3 = 256;
    const int NG = (NT + 3) >> 2;
#pragma unroll
    for (int pass = 0; pass < 2; ++pass) {
        const int shift = 21 - 11 * pass;
        __syncthreads();
#pragma unroll
        for (int i = 0; i < 16; ++i) *(LAS u32x4*)(hist + (lane + 64 * i) * 4) = (u32x4){0u, 0u, 0u, 0u};
        __syncthreads();
        const unsigned pa = hh ? pre2 : pre0, pb = hh ? pre3 : pre1;
        bf16x8 bc[4][2], bn[4][2];
        idx_load4(ikp, tokb, 0, NT, r, hh, bc);
        for (int g = 0; g < NG; ++g) {
            if (g + 1 < NG) idx_load4(ikp, tokb, (g + 1) * 4, NT, r, hh, bn);
#pragma unroll
            for (int u = 0; u < 4; ++u) {
                float sa, sb; idx_score2(a0, a1, bc[u][0], bc[u][1], wa, wb, sa, sb);
                const unsigned ka = fkey(sa), kb = fkey(sb);
                const bool live = g * 4 + u < NT;
                const unsigned ba = (ka >> shift) & 2047u, bb = (kb >> shift) & 2047u;
                if (live && (pass == 0 || (ka >> 21) == pa)) atomicAdd((unsigned*)&hist[(2 * hh) * 1024 + (ba >> 1)], 1u << (16 * (ba & 1u)));
                if (live && (pass == 0 || (kb >> 21) == pb)) atomicAdd((unsigned*)&hist[(2 * hh + 1) * 1024 + (bb >> 1)], 1u << (16 * (bb & 1u)));
            }
#pragma unroll
            for (int u = 0; u < 4; ++u) { bc[u][0] = bn[u][0]; bc[u][1] = bn[u][1]; }
        }
        __syncthreads();
#pragma unroll
        for (int q = 0; q < 4; ++q) {
            unsigned cw[16];
#pragma unroll
            for (int i = 0; i < 4; ++i) { const u32x4 c4 = *(const LAS u32x4*)(hist + q * 1024 + lane * 16 + i * 4); cw[4 * i] = c4.x; cw[4 * i + 1] = c4.y; cw[4 * i + 2] = c4.z; cw[4 * i + 3] = c4.w; }
            int s = 0;
#pragma unroll
            for (int i = 0; i < 16; ++i) s += (int)(cw[i] & 0xffffu) + (int)(cw[i] >> 16);
            int Ssum = s;
#pragma unroll
            for (int o = 1; o < 64; o <<= 1) { const int tv = __shfl_down(Ssum, o); if (lane + o < 64) Ssum += tv; }
            const int kr = q == 0 ? kr0 : q == 1 ? kr1 : q == 2 ? kr2 : kr3;
            const unsigned long long bal = __ballot(Ssum >= kr);
            const int ls = 63 - __builtin_clzll(bal | 1ull);
            int cum = Ssum - s, bin = 0, newk = 1; bool found = false;
#pragma unroll
            for (int bb = 31; bb >= 0; --bb) { const int c = (int)((cw[bb >> 1] >> (16 * (bb & 1))) & 0xffffu);
                if (!found && cum + c >= kr) { bin = lane * 32 + bb; newk = kr - cum; found = true; } if (!found) cum += c; }
            bin = __builtin_amdgcn_readlane(bin, ls); newk = __builtin_amdgcn_readlane(newk, ls);
            if (q == 0) { pre0 = (pre0 << 11) | (unsigned)bin; kr0 = newk; } else if (q == 1) { pre1 = (pre1 << 11) | (unsigned)bin; kr1 = newk; }
            else if (q == 2) { pre2 = (pre2 << 11) | (unsigned)bin; kr2 = newk; } else { pre3 = (pre3 << 11) | (unsigned)bin; kr3 = newk; }
        }
    }
    {
        const unsigned pa = hh ? pre2 : pre0, pb = hh ? pre3 : pre1;
        bf16x8 bc[4][2], bn[4][2];
        idx_load4(ikp, tokb, 0, NT, r, hh, bc);
        for (int g = 0; g < NG; ++g) {
            if (g + 1 < NG) idx_load4(ikp, tokb, (g + 1) * 4, NT, r, hh, bn);
#pragma unroll
            for (int u = 0; u < 4; ++u) {
                const int t = g * 4 + u;
                float sa, sb; idx_score2(a0, a1, bc[u][0], bc[u][1], wa, wb, sa, sb);
                const unsigned ka = fkey(sa) >> 10, kb = fkey(sb) >> 10;
                const unsigned long long ga = __ballot(ka > pa), ta = __ballot(ka == pa), gb = __ballot(kb > pb), tb = __ballot(kb == pb);
                if (t < NT) {
                    unsigned w[4] = {(unsigned)ga, (unsigned)gb, (unsigned)(ga >> 32), (unsigned)(gb >> 32)};
                    const unsigned tw[4] = {(unsigned)ta, (unsigned)tb, (unsigned)(ta >> 32), (unsigned)(tb >> 32)};
#pragma unroll
                    for (int q = 0; q < 4; ++q) {
                        int kr = q == 0 ? kr0 : q == 1 ? kr1 : q == 2 ? kr2 : kr3;
                        if (tw[q]) {
                            const int n = __popc(tw[q]);
                            if (n <= kr) { w[q] |= tw[q]; kr -= n; }
                            else { unsigned acc = 0u, tt = tw[q]; for (int k = 0; k < kr; ++k) { acc |= tt & (0u - tt); tt &= tt - 1u; } w[q] |= acc; kr = 0; }
                            if (q == 0) kr0 = kr; else if (q == 1) kr1 = kr; else if (q == 2) kr2 = kr; else kr3 = kr;
                        }
                    }
                    if (lane < 4) mask[(tokb + s0 + lane) * 128 + t] = lane == 0 ? w[0] : lane == 1 ? w[1] : lane == 2 ? w[2] : w[3];
                }
            }
#pragma unroll
            for (int u = 0; u < 4; ++u) { bc[u][0] = bn[u][0]; bc[u][1] = bn[u][1]; }
        }
    }
}

template <bool MLA>
DI void sm_attn_unit(LAS unsigned char* lds, const u16* qsrc, const u16* ksrc, const u16* krope, const u16* vt, const unsigned* mask, const int* positions, const double* invf, const float* qg,
                     u16* mixed, int b, int h, int qb8) {
    constexpr int DK = MLA ? 96 : 64, NKK = DK / 16, KPI = DK + 8, KELEMS = 64 * KPI, BUFE = KELEMS + 64 * KP;
    int tid = threadIdx.x;
    asm volatile("" : "+v"(tid));
    const int lane = tid & 63, wave = __builtin_amdgcn_readfirstlane(tid >> 6), r = lane & 31, hh = lane >> 5;
    LAS u16* lbase = (LAS u16*)lds;
    const int q0 = qb8 * 512 + wave * 64;
    const size_t tokb = (size_t)b * S_;
    bf16x8 qf[2][NKK];
#pragma unroll
    for (int qs = 0; qs < 2; ++qs) {
        const size_t tokq = tokb + q0 + qs * 32 + r;
        if constexpr (MLA) {
            float f[NKK][8]; float ss = 0.f;
#pragma unroll
            for (int kk = 0; kk < NKK; ++kk) { unpack8(*(const u32x4*)(qsrc + tokq * 768 + h * 96 + kk * 16 + hh * 8), f[kk]);
#pragma unroll
                for (int j = 0; j < 8; ++j) ss += f[kk][j] * f[kk][j]; }
            ss += xor32(ss, hh);
            const float rr = rsqrtf(ss * (1.f / 96.f) + EPS);
#pragma unroll
            for (int kk = 0; kk < NKK; ++kk)
#pragma unroll
                for (int j = 0; j < 8; ++j) f[kk][j] = f[kk][j] * rr * qg[kk * 16 + hh * 8 + j];
            const int pos = positions[tokq];
#pragma unroll
            for (int j = 0; j < 8; ++j) { float c, s; sincos_rev(pos, invf[hh * 8 + j], c, s); const float x1 = f[0][j], x2 = f[1][j]; f[0][j] = x1 * c - x2 * s; f[1][j] = x2 * c + x1 * s; }
#pragma unroll
            for (int kk = 0; kk < NKK; ++kk) qf[qs][kk] = __builtin_bit_cast(bf16x8, pack8(f[kk]));
        } else {
#pragma unroll
            for (int kk = 0; kk < NKK; ++kk) qf[qs][kk] = *(const bf16x8*)(qsrc + tokq * CD_PAD + 416 + h * 64 + kk * 16 + hh * 8);
        }
    }
    const float sc2 = (MLA ? 0.10206207261596575f : 0.125f) * 1.4426950408889634f;
    f32x16 o[2][2];
#pragma unroll
    for (int qs = 0; qs < 2; ++qs)
#pragma unroll
        for (int dt = 0; dt < 2; ++dt)
#pragma unroll
            for (int i = 0; i < 16; ++i) o[qs][dt][i] = 0.f;
    float m[2] = {-1.0e29f, -1.0e29f}, l[2] = {0.f, 0.f};
    const int kt_end = qb8 * 8 + wave, kt_last = qb8 * 8 + 7;
    const int vrow = tid >> 3, vc8 = (tid & 7) * 8;
    const u16* vgp = vt + ((size_t)(b * 8 + h) * 64 + vrow) * S_ + vc8;
    constexpr size_t kstride0 = MLA ? (size_t)64 * 1024 : (size_t)64 * CD_PAD, kstride1 = 64 * 32;
    const bool has1 = MLA && tid < 256;
    const u16* kgp0 = MLA ? ksrc + (tokb + vrow) * 1024 + h * 128 + vc8 : ksrc + (tokb + vrow) * CD_PAD + 928 + h * 64 + vc8;
    const u16* kgp1 = krope + (tokb + (tid >> 2)) * 32 + (tid & 3) * 8;
    const int kl0 = vrow * KPI + (MLA ? 32 : 0) + vc8, kl1 = (tid >> 2) * KPI + (tid & 3) * 8;
    const int vl = KELEMS + vrow * KP + vc8;
    u32x4 kreg0 = *(const u32x4*)kgp0, kreg1 = (u32x4){0u, 0u, 0u, 0u}, vreg = *(const u32x4*)vgp;
    if (has1) kreg1 = *(const u32x4*)kgp1;
    const unsigned* mrowA = mask + (tokb + q0 + r) * 128; const unsigned* mrowB = mrowA + 32 * 128;
    u32x2 mwA = (u32x2){0xffffffffu, 0xffffffffu}, mwB = mwA, mwnA = mwA, mwnB = mwA;
    if constexpr (!MLA) { mwnA = *(const u32x2*)mrowA; mwnB = *(const u32x2*)mrowB; }
    __syncthreads();
    *(LAS u32x4*)(lbase + kl0) = kreg0; if (has1) *(LAS u32x4*)(lbase + kl1) = kreg1; *(LAS u32x4*)(lbase + vl) = vreg;
    if (kt_last >= 1) { kreg0 = *(const u32x4*)(kgp0 + kstride0); if (has1) kreg1 = *(const u32x4*)(kgp1 + kstride1); vreg = *(const u32x4*)(vgp + 64); }
    for (int kt = 0; kt <= kt_last; ++kt) {
        __syncthreads();
        LAS u16* Kc = lbase + (kt & 1) * BUFE; LAS u16* Vc = Kc + KELEMS; LAS u16* nb = lbase + ((kt + 1) & 1) * BUFE;
        if (kt + 1 <= kt_last) { *(LAS u32x4*)(nb + kl0) = kreg0; if (has1) *(LAS u32x4*)(nb + kl1) = kreg1; *(LAS u32x4*)(nb + vl) = vreg; }
        if (kt + 2 <= kt_last) {
            kreg0 = *(const u32x4*)(kgp0 + (size_t)(kt + 2) * kstride0);
            if (has1) kreg1 = *(const u32x4*)(kgp1 + (size_t)(kt + 2) * kstride1);
            vreg = *(const u32x4*)(vgp + (kt + 2) * 64);
        }
        if constexpr (!MLA) { mwA = mwnA; mwB = mwnB; if (kt + 1 <= kt_end) { mwnA = *(const u32x2*)(mrowA + 2 * (kt + 1)); mwnB = *(const u32x2*)(mrowB + 2 * (kt + 1)); } }
        if (kt > kt_end) continue;
        f32x16 sb[2];
#pragma unroll
        for (int i = 0; i < 16; ++i) sb[0][i] = 0.f;
#pragma unroll
        for (int kk = 0; kk < NKK; ++kk) {
            const bf16x8 kf = *(const LAS bf16x8*)(Kc + r * KPI + kk * 16 + hh * 8);
            sb[0] = __builtin_amdgcn_mfma_f32_32x32x16_bf16(kf, qf[0][kk], sb[0], 0, 0, 0);
        }
#pragma unroll
        for (int n = 0; n < 4; ++n) {
            const int ks = n >> 1, qs = n & 1;
            f32x16& sc = sb[n & 1];
            if constexpr (!MLA) {
                const unsigned mword = qs == 0 ? (ks ? mwA.y : mwA.x) : (ks ? mwB.y : mwB.x);
#pragma unroll
                for (int i = 0; i < 16; ++i) { const int bit = (i & 3) + 8 * (i >> 2) + 4 * hh; sc[i] = ((mword >> bit) & 1u) ? sc[i] : -1.0e30f; }
            }
            float mx = fmaxf(fmaxf(sc[0], sc[1]), sc[2]);
#pragma unroll
            for (int i = 3; i < 15; i += 2) mx = fmaxf(fmaxf(mx, sc[i]), sc[i + 1]);
            mx = fmaxf(mx, sc[15]);
            mx = fmaxf(mx, xor32(mx, hh));
            const float mnew = fmaxf(m[qs], mx * sc2);
            if (__any(mnew != m[qs])) {
                const float alpha = __builtin_amdgcn_exp2f(m[qs] - mnew);
                l[qs] *= alpha;
#pragma unroll
                for (int i = 0; i < 16; ++i) { o[qs][0][i] *= alpha; o[qs][1][i] *= alpha; }
                m[qs] = mnew;
            }
            if (n < 3) {
                const int ks1 = (n + 1) >> 1, qs1 = (n + 1) & 1;
                f32x16& sn = sb[(n + 1) & 1];
#pragma unroll
                for (int i = 0; i < 16; ++i) sn[i] = 0.f;
#pragma unroll
                for (int kk = 0; kk < NKK; ++kk) {
                    const bf16x8 kf = *(const LAS bf16x8*)(Kc + (ks1 * 32 + r) * KPI + kk * 16 + hh * 8);
                    sn = __builtin_amdgcn_mfma_f32_32x32x16_bf16(kf, qf[qs1][kk], sn, 0, 0, 0);
                }
            }
            float lsum = 0.f;
            const float nm = -mnew;
#pragma unroll
            for (int i = 0; i < 16; ++i) { const float p = __builtin_amdgcn_exp2f(__builtin_fmaf(sc[i], sc2, nm)); sc[i] = p; lsum += p; }
            l[qs] += lsum;
#pragma unroll
            for (int s2 = 0; s2 < 2; ++s2) {
                u32x4 pw; pw.x = pack_bf2(sc[8 * s2 + 0], sc[8 * s2 + 1]); pw.y = pack_bf2(sc[8 * s2 + 2], sc[8 * s2 + 3]);
                pw.z = pack_bf2(sc[8 * s2 + 4], sc[8 * s2 + 5]); pw.w = pack_bf2(sc[8 * s2 + 6], sc[8 * s2 + 7]);
                const bf16x8 pf = __builtin_bit_cast(bf16x8, pw);
#pragma unroll
                for (int dt = 0; dt < 2; ++dt) {
                    const bf16x8 vf = *(const LAS bf16x8*)(Vc + (dt * 32 + r) * KP + (ks * 2 + s2) * 16 + hh * 8);
                    o[qs][dt] = __builtin_amdgcn_mfma_f32_32x32x16_bf16(vf, pf, o[qs][dt], 0, 0, 0);
                }
            }
        }
    }
#pragma unroll
    for (int qs = 0; qs < 2; ++qs) {
        const float lt = l[qs] + xor32(l[qs], hh);
        const float inv = 1.f / lt;
        u16* orow = mixed + (tokb + q0 + qs * 32 + r) * D_ + (MLA ? 0 : 512) + h * 64;
#pragma unroll
        for (int g = 0; g < 4; ++g) {
            u32x2 w0, w1;
            w0.x = pack_bf2(o[qs][0][4 * g] * inv, o[qs][0][4 * g + 1] * inv); w0.y = pack_bf2(o[qs][0][4 * g + 2] * inv, o[qs][0][4 * g + 3] * inv);
            w1.x = pack_bf2(o[qs][1][4 * g] * inv, o[qs][1][4 * g + 1] * inv); w1.y = pack_bf2(o[qs][1][4 * g + 2] * inv, o[qs][1][4 * g + 3] * inv);
            *(u32x2*)(orow + 8 * g + 4 * hh) = w0;
            *(u32x2*)(orow + 32 + 8 * g + 4 * hh) = w1;
        }
    }
}

#define MOE_LAYER(base, layer) \
    if (IN(base)) { \
        int cb = 0; \
        for (int e = 0; e < 16; ++e) { \
            cb = cvt_matrix(lds, cb, P.in[27] + ((size_t)(layer) * 16 + e) * 1024 * 512, 1024, 512, 512, W_gu + (size_t)e * 1024 * 1024, 1024, 1); \
            cb = cvt_matrix(lds, cb, P.in[28] + ((size_t)(layer) * 16 + e) * 1024 * 512, 1024, 512, 512, W_gu + (size_t)e * 1024 * 1024, 1024, 2); \
            cb = cvt_matrix(lds, cb, P.in[29] + ((size_t)(layer) * 16 + e) * 512 * 1024, 512, 1024, 1024, W_dn + (size_t)e * 1024 * 512, 512, 0); } \
        router_phase(lds, P.out, P.in[22] + (layer) * 1024, P.in[23] + (layer) * 4096, P.in[24] + (layer) * 4, P.in[25] + (layer) * 16384, P.in[26] + (layer) * 16, XN, TOK_E, TOK_C, CNT); \
    } \
    SEAM(base); \
    if (IN((base) + 1)) scatter_phase(lds, XN, TOK_E, CNT, TOK_POS, SEG, XS); \
    SEAM((base) + 1); \
    if (IN((base) + 2)) { \
        LAS int* segl = (LAS int*)(lds + LDS_TAB + 128); if (tid < 17) segl[tid] = SEG[tid]; __syncthreads(); \
        pg8::Gemm g{XS, W_gu, 1024, 1024, 1024}; pg8::MoeOrder S{segl, (int)gridDim.x, vcu}; pg8::EpiGU E{HID}; \
        pg8::gemm_phase(lds, g, S, E); \
    } \
    SEAM((base) + 2); \
    if (IN((base) + 3)) { \
        LAS int* segl = (LAS int*)(lds + LDS_TAB + 128); if (tid < 17) segl[tid] = SEG[tid]; __syncthreads(); \
        pg8::Gemm g{HID, W_dn, 512, 512, 512}; pg8::MoeOrder S{segl, (int)gridDim.x, vcu}; pg8::EpiBf16 E{YB, 1024, 3}; \
        pg8::gemm_phase(lds, g, S, E); \
    } \
    SEAM((base) + 3);

__global__ void __launch_bounds__(512, 2) fwd(Params P) {
    extern __shared__ __attribute__((aligned(16))) unsigned char shm[];
    LAS unsigned char* lds = (LAS unsigned char*)shm;
    const int tid = threadIdx.x;
    if (tid == 0) { volatile LAS unsigned* st = (volatile LAS unsigned*)(lds + LDS_BARW); st[0] = 0u; st[1] = 0u; st[2] = 0u; st[3] = 0u; }
    __syncthreads();
    unsigned char* ws = P.ws;
    XcdBarrier bar = xcd_barrier_post((unsigned*)(ws + WS_CTL), (volatile LAS unsigned*)(lds + LDS_BARW));
    const int lo = P.ph_lo, hi = P.ph_hi;
#define IN(k) (lo <= (k) && (k) < hi)
#define SEAM(k) do { if (IN(k) && IN((k) + 1)) xcd_barrier(bar); } while (0)

    const float* x = P.in[0];
    u16* W_abin = (u16*)(ws + WS_WABIN); u16* W_about = (u16*)(ws + WS_WABOUT); u16* W_sgu = (u16*)(ws + WS_WSGU);
    u16* W_gu = (u16*)(ws + WS_WGU); u16* W_dn = (u16*)(ws + WS_WDN);
    u16* XS = (u16*)(ws + WS_R1); u16* HID = (u16*)(ws + WS_R2); u16* YB = (u16*)(ws + WS_R4);
    int* TOK_E = (int*)(ws + WS_MISC + MISC_TOKE); float* TOK_C = (float*)(ws + WS_MISC + MISC_TOKC); int* TOK_POS = (int*)(ws + WS_MISC + MISC_POS);
    int* CNT = (int*)(ws + WS_MISC + MISC_CNT); int* SEG = (int*)(ws + WS_MISC + MISC_SEG);
    const int vcu = (gridDim.x % 8 == 0) ? (int)((blockIdx.x % 8) * (gridDim.x / 8) + blockIdx.x / 8) : (int)blockIdx.x;
    u16* W_cdin = (u16*)(ws + WS_WCDIN); u16* W_uq = (u16*)(ws + WS_WUQ); u16* W_ukv = (u16*)(ws + WS_WUKV); u16* W_cdout = (u16*)(ws + WS_WCDOUT);
    u16* PROJ1 = (u16*)(ws + WS_PROJ1); unsigned* MASK = (unsigned*)(ws + WS_MASK); u16* KVR = (u16*)(ws + WS_KVR); u16* LAT = (u16*)(ws + WS_LAT); u16* QCR = (u16*)(ws + WS_QCR);
    u16* VCT = (u16*)(ws + WS_VCT); u16* VDT = (u16*)(ws + WS_VDT); u16* KROPE = (u16*)(ws + WS_MISC + MISC_KROPE); u16* IKP = (u16*)(ws + WS_MISC + MISC_IKP); float* IWP = (float*)(ws + WS_MISC + MISC_IWP);
    const int* positions = (const int*)P.in[1];
    u16* XN = (u16*)(ws + WS_XN); u16* PROJ = (u16*)(ws + WS_PROJ); u16* VT = (u16*)(ws + WS_VT); u16* ZT = (u16*)(ws + WS_ZT); u16* MIXED = (u16*)(ws + WS_MIXED);

    if (IN(0)) {
        int base = 0;
        base = cvt_matrix(lds, base, P.in[3], 1024, AB_COLS, AB_COLS, W_abin, 1024, 0);
        base = cvt_matrix(lds, base, P.in[9], 1024, 1024, 1024, W_about, 1024, 0);
        base = cvt_matrix(lds, base, P.in[11], 1024, CD_PAD, CD_COLS, W_cdin, 1024, 0);
        base = cvt_matrix(lds, base, P.in[14], 256, 768, 768, W_uq, 256, 0);
        base = cvt_matrix(lds, base, P.in[15], 128, 1024, 1024, W_ukv, 256, 0);
        base = cvt_matrix(lds, base, P.in[21], 1024, 1024, 1024, W_cdout, 1024, 0);
        for (int e = blockIdx.x * 512 + tid; e < 1024 * 16; e += gridDim.x * 512) *(u32x4*)(W_ukv + (size_t)(e >> 4) * 256 + 128 + (e & 15) * 8) = (u32x4){0u, 0u, 0u, 0u};
        for (int e = blockIdx.x * 512 + tid; e < 8 * 128 * 128 / 2; e += gridDim.x * 512) {
            const int j = (e * 2) & 127, i = ((e * 2) >> 7) & 127;
            const float a = P.in[7][e * 2], c = P.in[7][e * 2 + 1];
            const bool vis = (j >> 6) <= (i >> 6);
            ((unsigned*)W_sgu)[e] = vis ? pack_bf2(a, c) : 0u;
        }
        rmsnorm_rows(x, P.in[2], XN);
    }
    SEAM(0);
    if (IN(1)) {
        pg8::Gemm g{XN, W_abin, 1024, 1024, 1024}; pg8::StaticOrder S; S.init(T_, AB_COLS, gridDim.x, blockIdx.x);
        pg8::EpiBf16 E{PROJ, AB_COLS, 0x7fffffff};
        pg8::gemm_phase(lds, g, S, E);
    }
    SEAM(1);
    if (IN(2)) post_l0(lds, PROJ, P.in[4], P.in[5], P.in[6], VT, ZT);
    SEAM(2);
    if (IN(3)) {
        for (int p = blockIdx.x; p < 256; p += gridDim.x) {
            const int bh = p >> 3, pi = p & 7, b = bh >> 3, h = bh & 7;
            sb_attn_unit(lds, PROJ, VT, MIXED, b, h, 15 - pi);
            sb_attn_unit(lds, PROJ, VT, MIXED, b, h, pi);
        }
        for (int u = blockIdx.x; u < 1024; u += gridDim.x) {
            const int g = u & 7, n = (u >> 3) & 31, b = u >> 8;
            sgu_unit(ZT, W_sgu, P.in[8], PROJ, MIXED, b, n, g);
        }
    }
    SEAM(3);
    if (IN(4)) {
        pg8::Gemm g{MIXED, W_about, 1024, 1024, 1024}; pg8::StaticOrder S; S.init(T_, 1024, gridDim.x, blockIdx.x);
        pg8::EpiF32Res E{P.out, x, 1024};
        pg8::gemm_phase(lds, g, S, E);
    }
    SEAM(4);
    MOE_LAYER(5, 0)
    if (IN(9)) combine_phase(P.out, YB, TOK_POS, TOK_C, P.in[10], XN);
    SEAM(9);
    if (IN(10)) {
        pg8::Gemm g{XN, W_cdin, 1024, 1024, 1024}; pg8::StaticOrder S; S.init(T_, CD_PAD, gridDim.x, blockIdx.x);
        pg8::EpiBf16 E{PROJ1, CD_PAD, 0x7fffffff};
        pg8::gemm_phase(lds, g, S, E);
    }
    SEAM(10);
    if (IN(11)) post_l1a(lds, PROJ1, positions, P.invf, P.in[12], P.in[13], P.in[18], P.in[19], P.in[20], LAT, KROPE, IKP, IWP, VDT);
    SEAM(11);
    if (IN(12)) {
        { pg8::Gemm g{LAT, W_uq, 512, 256, 256}; pg8::StaticOrder S; S.init(T_, 768, gridDim.x, blockIdx.x); pg8::EpiBf16 E{QCR, 768, 0x7fffffff}; pg8::gemm_phase(lds, g, S, E); }
        { pg8::Gemm g{LAT + 256, W_ukv, 512, 256, 256}; pg8::StaticOrder S; S.init(T_, 1024, gridDim.x, blockIdx.x); pg8::EpiBf16 E{KVR, 1024, 0x7fffffff}; pg8::gemm_phase(lds, g, S, E); }
    }
    SEAM(12);
    if (IN(13)) {
        post_l1b(lds, KVR, P.in[17], VCT);
        for (int p = blockIdx.x; p < 256; p += gridDim.x) {
            const int b = p >> 6, pj = p & 63;
            indexer_unit(lds, PROJ1, IKP, IWP, MASK, b, 127 - pj);
            __syncthreads();
            indexer_unit(lds, PROJ1, IKP, IWP, MASK, b, pj);
            __syncthreads();
        }
    }
    SEAM(13);
    if (IN(14)) {
        for (int p = blockIdx.x; p < 256; p += gridDim.x) {
            const int bh = p >> 3, pi = p & 7, b = bh >> 3, h = bh & 7;
            sm_attn_unit<true>(lds, QCR, KVR, KROPE, VCT, MASK, positions, P.invf, P.in[16], MIXED, b, h, pi);
            sm_attn_unit<false>(lds, PROJ1, PROJ1, KROPE, VDT, MASK, positions, P.invf, P.in[16], MIXED, b, h, 7 - pi);
        }
    }
    SEAM(14);
    if (IN(15)) {
        pg8::Gemm g{MIXED, W_cdout, 1024, 1024, 1024}; pg8::StaticOrder S; S.init(T_, 1024, gridDim.x, blockIdx.x);
        pg8::EpiF32Res E{P.out, P.out, 1024};
        pg8::gemm_phase(lds, g, S, E);
    }
    SEAM(15);
    MOE_LAYER(16, 1)
    if (IN(20)) combine_phase(P.out, YB, TOK_POS, TOK_C, nullptr, XN);
}

extern "C" void kernel_launch(void* const* d_in, const int* in_sizes, int n_in, void* d_out, int out_size, void* d_ws, size_t ws_size, hipStream_t stream) {
    static int grid = 0;
    if (grid == 0) {
        if (n_in != 30 || out_size != T_ * D_ || ws_size < WS_END) { fprintf(stderr, "kernel_launch: unexpected shapes (n_in %d out %d ws %zu need %zu)\n", n_in, out_size, ws_size, (size_t)WS_END); grid = -1; return; }
        int dev = 0, cus = 0;
        if (hipGetDevice(&dev) != hipSuccess || hipDeviceGetAttribute(&cus, hipDeviceAttributeMultiprocessorCount, dev) != hipSuccess) { grid = -1; return; }
        if (hipFuncSetAttribute((const void*)fwd, hipFuncAttributeMaxDynamicSharedMemorySize, LDS_BYTES) != hipSuccess) { fprintf(stderr, "kernel_launch: hipFuncSetAttribute failed\n"); grid = -1; return; }
        int per_cu = 0;
        if (hipOccupancyMaxActiveBlocksPerMultiprocessor(&per_cu, (const void*)fwd, 512, LDS_BYTES) != hipSuccess || per_cu < 1) fprintf(stderr, "kernel_launch: occupancy query says %d\n", per_cu);
        (void)hipGetLastError();
        grid = cus;
    }
    if (grid < 0) return;
    (void)hipMemsetAsync((char*)d_ws + WS_CTL, 0, CTL_BYTES, stream);
    Params p{};
    for (int i = 0; i < 30; ++i) p.in[i] = (const float*)d_in[i];
    p.out = (float*)d_out; p.ws = (unsigned char*)d_ws; p.ph_lo = 0; p.ph_hi = 21;
    for (int i = 0; i < 16; ++i) p.invf[i] = pow(500000.0, -(double)i * (2.0 / 32.0));
    for (int i = 0; i < 8; ++i) p.invf[16 + i] = pow(500000.0, -(double)i * (2.0 / 16.0));
    for (int i = 0; i < 4; ++i) p.invf[24 + i] = pow(500000.0, -(double)i * (2.0 / 8.0));
    hipLaunchKernelGGL(fwd, dim3(grid), dim3(512), LDS_BYTES, stream, p);
}
```
